# Optimizing an MI355X kernel written in HIP

```python
import jax, jax.numpy as jnp
from jax import lax
import numpy as np

D_MODEL = 1024
BATCH = 8
SEQ = 4096
DEPTH = 4

N_MIXERS = 4
EPS = 1e-6
POOL_WINDOWS = (2, 4, 8, 16)
POOL_GROUPS = len(POOL_WINDOWS)
POOL_GROUP_DIM = D_MODEL // POOL_GROUPS
HGRN_HEAD_DIM = 128
HGRN_HEADS = D_MODEL // HGRN_HEAD_DIM
HGRN_CHUNK = 64
SWA_HEADS = 16
SWA_KV_HEADS = 4
SWA_HEAD_DIM = D_MODEL // SWA_HEADS
SWA_WINDOW = 128
SWA_QKV_DIM = (SWA_HEADS + 2 * SWA_KV_HEADS) * SWA_HEAD_DIM
CONV_WIDTH = 3
N_EXPERTS = 16
N_GROUPS = 4
EXPERTS_PER_GROUP = N_EXPERTS // N_GROUPS
TOP_K = 2
D_FF_EXPERT = 1024
MOE_BLOCK = 128

kernel_name = 'hybrid_interleaved_pool_hgrn2_swa_conv_moe'


def _n_occ(m):
    return len(range(m, DEPTH, N_MIXERS))


def rmsnorm(x, g):
    xf = x.astype(jnp.float32)
    y = xf * lax.rsqrt(jnp.mean(xf * xf, axis=-1, keepdims=True) + EPS)
    return (y * g.astype(jnp.float32)).astype(x.dtype)


def pool_mixer(h, w_in, w_grp, scale, w_out):
    B, T, D = h.shape
    u = (h @ w_in).astype(jnp.float32).reshape(B, T, POOL_GROUPS, POOL_GROUP_DIM)
    cs = jnp.concatenate([jnp.zeros_like(u[:, :1]), jnp.cumsum(u, axis=1)], axis=1)
    pos = jnp.arange(T)
    pooled = []
    for g, w in enumerate(POOL_WINDOWS):
        lo = jnp.maximum(pos + 1 - w, 0)
        cnt = jnp.minimum(pos + 1, w).astype(jnp.float32)
        pooled.append((cs[:, 1:, g] - cs[:, lo, g]) / cnt[None, :, None])
    pooled = jnp.stack(pooled, axis=2) - u
    y = jnp.einsum('btgc,gcd->btgd', pooled, w_grp.astype(jnp.float32)).reshape(B, T, D)
    y = y * scale.astype(jnp.float32)
    return y.astype(h.dtype) @ w_out


def hgrn2_chunked(q, k, v, log_f):
    B, H, T, dk = q.shape
    dv = v.shape[-1]
    N = T // HGRN_CHUNK

    def chunks(a):
        return a.reshape(B, H, N, HGRN_CHUNK, a.shape[-1]).transpose(2, 0, 1, 3, 4)

    causal = jnp.tril(jnp.ones((HGRN_CHUNK, HGRN_CHUNK), bool))[:, :, None]

    def step(S, inp):
        qc, kc, vc, gc = inp
        b = jnp.cumsum(gc, axis=-2)
        rel = jnp.exp(jnp.where(causal, b[..., :, None, :] - b[..., None, :, :], -jnp.inf))
        scores = jnp.einsum('bhtd,bhsd,bhtsd->bhts', qc, kc, rel)
        o = scores @ vc + jnp.einsum('bhtd,bhdv->bhtv', qc * jnp.exp(b), S)
        b_last = b[..., -1:, :]
        S = S * jnp.exp(b_last[:, :, 0, :, None]) + jnp.einsum(
            'bhsd,bhsv->bhdv', kc * jnp.exp(b_last - b), vc)
        return S, o

    S0 = jnp.zeros((B, H, dk, dv), jnp.float32)
    _, o = lax.scan(step, S0, (chunks(q), chunks(k), chunks(v), chunks(log_f)))
    return o.transpose(1, 2, 0, 3, 4).reshape(B, H, T, dv)


def hgrn2_mixer(h, w_in, lower_bound, norm_g, w_out):
    B, T, D = h.shape
    H, dk = HGRN_HEADS, HGRN_HEAD_DIM
    q, f_logit, v, g = jnp.split(h @ w_in, 4, axis=-1)

    def heads(a):
        return a.astype(jnp.float32).reshape(B, T, H, dk).transpose(0, 2, 1, 3)

    q = jax.nn.silu(heads(q))
    lb = lower_bound.astype(jnp.float32).reshape(H, dk)[None, :, None, :]
    f = lb + (1.0 - lb) * jax.nn.sigmoid(heads(f_logit))
    o = hgrn2_chunked(q, 1.0 - f, heads(v), jnp.log(f))
    o = rmsnorm(o, norm_g)
    o = o.transpose(0, 2, 1, 3).reshape(B, T, D) * jax.nn.silu(g.astype(jnp.float32))
    return o.astype(h.dtype) @ w_out


def swa_mixer(h, w_in, sinks, w_out):
    B, T, D = h.shape
    Hq, Hk, hd, W = SWA_HEADS, SWA_KV_HEADS, SWA_HEAD_DIM, SWA_WINDOW
    G = Hq // Hk
    nb = T // W
    q, k, v = jnp.split(h @ w_in, [Hq * hd, (Hq + Hk) * hd], axis=-1)
    q = q.astype(jnp.float32).reshape(B, nb, W, Hk, G, hd) * (hd ** -0.5)

    def kv_blocks(a):
        a = a.astype(jnp.float32).reshape(B, nb, W, Hk, hd)
        prev = jnp.concatenate([jnp.zeros_like(a[:, :1]), a[:, :-1]], axis=1)
        return jnp.concatenate([prev, a], axis=2)

    kb, vb = kv_blocks(k), kv_blocks(v)
    s = jnp.einsum('bnqhgd,bnkhd->bnhgqk', q, kb)
    qi = jnp.arange(W)[:, None]
    kj = jnp.arange(2 * W)[None, :]
    diff = qi + W - kj
    band = (diff >= 0) & (diff < W)
    mask = band[None] & ((jnp.arange(nb)[:, None, None] > 0) | (kj >= W)[None])
    s = jnp.where(mask[None, :, None, None], s, -jnp.inf)
    sink = sinks.astype(jnp.float32).reshape(Hk, G)[None, None, :, :, None, None]
    m = jnp.maximum(jnp.max(s, axis=-1, keepdims=True), sink)
    p = jnp.exp(s - m)
    denom = jnp.sum(p, axis=-1, keepdims=True) + jnp.exp(sink - m)
    o = jnp.einsum('bnhgqk,bnkhd->bnqhgd', p / denom, vb)
    return o.reshape(B, T, D).astype(h.dtype) @ w_out


def conv_mixer(h, w_in, conv_w, w_out):
    D = h.shape[-1]
    b_gate, c_gate, u = jnp.split(h @ w_in, 3, axis=-1)
    z = c_gate * u
    zc = lax.conv_general_dilated(
        z, conv_w[:, None, :].astype(z.dtype), window_strides=(1,),
        padding=[(CONV_WIDTH - 1, 0)], dimension_numbers=('NWC', 'WIO', 'NWC'),
        feature_group_count=D)
    return (b_gate * zc) @ w_out


def route(h2d, router_w, router_bias):
    scores = jax.nn.sigmoid((h2d @ router_w).astype(jnp.float32))
    sel = scores + router_bias.astype(jnp.float32)
    grp = sel.reshape(-1, N_GROUPS, EXPERTS_PER_GROUP)
    group_score = jnp.sum(lax.top_k(grp, TOP_K)[0], axis=-1)
    best = jnp.argmax(group_score, axis=-1)
    in_group = (jnp.arange(N_EXPERTS) // EXPERTS_PER_GROUP)[None, :] == best[:, None]
    _, idx = lax.top_k(jnp.where(in_group, sel, -jnp.inf), TOP_K)
    w = jnp.take_along_axis(scores, idx, axis=-1)
    return idx, w / jnp.sum(w, axis=-1, keepdims=True)


def moe_ffn(h2d, idx, w, w_gate, w_up, w_down):
    T, D = h2d.shape
    A = T * TOP_K
    flat_e = idx.reshape(A)
    order = jnp.argsort(flat_e)
    e_sorted = flat_e[order]
    tok = order // TOP_K
    counts = jnp.bincount(flat_e, length=N_EXPERTS)
    padded = (counts + MOE_BLOCK - 1) // MOE_BLOCK * MOE_BLOCK
    ends_pad = jnp.cumsum(padded)
    starts_pad = ends_pad - padded
    starts = jnp.cumsum(counts) - counts
    dest = starts_pad[e_sorted] + jnp.arange(A) - starts[e_sorted]
    n_blocks = -(-A // MOE_BLOCK) + N_EXPERTS
    slot_tok = jnp.full((n_blocks * MOE_BLOCK,), T, jnp.int32).at[dest].set(tok.astype(jnp.int32))
    x_pad = jnp.concatenate([h2d, jnp.zeros((1, D), h2d.dtype)], axis=0)
    xb = x_pad[slot_tok].reshape(n_blocks, MOE_BLOCK, D)
    block_e = jnp.minimum(
        jnp.searchsorted(ends_pad, jnp.arange(n_blocks) * MOE_BLOCK, side='right'), N_EXPERTS - 1)

    def expert_block(args):
        xblk, e = args
        a = jax.nn.silu(xblk @ w_gate[e]) * (xblk @ w_up[e])
        return a @ w_down[e]

    yb = lax.map(expert_block, (xb, block_e)).reshape(-1, D)
    y = yb[dest] * w.reshape(A)[order][:, None].astype(yb.dtype)
    return jnp.zeros((T, D), yb.dtype).at[tok].add(y)


def setup_inputs(seed: int = 0) -> dict:
    key = jax.random.key(seed)
    ks = jax.random.split(key, 24)
    D, F, E = D_MODEL, D_FF_EXPERT, N_EXPERTS
    nA, nB, nC, nD = _n_occ(0), _n_occ(1), _n_occ(2), _n_occ(3)
    n = lambda k, shape, s: jax.random.normal(k, shape, jnp.float32) * s
    return {
        'x': n(ks[0], (BATCH, SEQ, D), 1.0),
        'c': n(ks[1], (BATCH, D), 1.0),
        'ada_w': n(ks[2], (DEPTH, D, 6 * D), 0.5 * D ** -0.5),
        'ada_b': n(ks[3], (DEPTH, 6 * D), 0.02),
        'norm_g': 1.0 + n(ks[4], (DEPTH, 2, D), 0.05),
        'final_norm_g': 1.0 + n(ks[5], (D,), 0.05),
        'pool_w_in': n(ks[6], (nA, D, D), D ** -0.5),
        'pool_w_grp': n(ks[7], (nA, POOL_GROUPS, POOL_GROUP_DIM, POOL_GROUP_DIM), POOL_GROUP_DIM ** -0.5),
        'pool_scale': 1.0 + n(ks[8], (nA, D), 0.1),
        'pool_w_out': n(ks[9], (nA, D, D), D ** -0.5),
        'hgrn_w_in': n(ks[10], (nB, D, 4 * D), D ** -0.5),
        'hgrn_lb_logits': n(ks[11], (DEPTH, D), 0.1),
        'hgrn_norm_g': 1.0 + n(ks[12], (nB, HGRN_HEAD_DIM), 0.05),
        'hgrn_w_out': n(ks[13], (nB, D, D), D ** -0.5),
        'swa_w_in': n(ks[14], (nC, D, SWA_QKV_DIM), D ** -0.5),
        'swa_sinks': n(ks[15], (nC, SWA_HEADS), 0.5),
        'swa_w_out': n(ks[16], (nC, D, D), D ** -0.5),
        'conv_w_in': n(ks[17], (nD, D, 3 * D), D ** -0.5),
        'conv_w': n(ks[18], (nD, CONV_WIDTH, D), CONV_WIDTH ** -0.5),
        'conv_w_out': n(ks[19], (nD, D, D), D ** -0.5),
        'router_w': n(ks[20], (D, E), D ** -0.5),
        'router_bias': n(ks[21], (E,), 0.01),
        'moe_w_gate': n(ks[22], (DEPTH, E, D, F), D ** -0.5),
        'moe_w_up': n(jax.random.fold_in(ks[22], 1), (DEPTH, E, D, F), D ** -0.5),
        'moe_w_down': n(ks[23], (DEPTH, E, F, D), F ** -0.5),
    }


def reference(x, c, ada_w, ada_b, norm_g, final_norm_g,
              pool_w_in, pool_w_grp, pool_scale, pool_w_out,
              hgrn_w_in, hgrn_lb_logits, hgrn_norm_g, hgrn_w_out,
              swa_w_in, swa_sinks, swa_w_out,
              conv_w_in, conv_w, conv_w_out,
              router_w, router_bias, moe_w_gate, moe_w_up, moe_w_down):
    B, T, D = x.shape
    lb_all = jnp.cumsum(jax.nn.softmax(hgrn_lb_logits.astype(jnp.float32), axis=0), axis=0)
    lb_all = lb_all - lb_all[0]
    cond = jax.nn.silu(c)
    for i in range(DEPTH):
        m, j = i % N_MIXERS, i // N_MIXERS
        mod = cond @ ada_w[i] + ada_b[i]
        sh1, sc1, g1, sh2, sc2, g2 = [a[:, None, :] for a in jnp.split(mod, 6, axis=-1)]
        h = rmsnorm(x, norm_g[i, 0]) * (1.0 + sc1) + sh1
        if m == 0:
            y = pool_mixer(h, pool_w_in[j], pool_w_grp[j], pool_scale[j], pool_w_out[j])
        elif m == 1:
            y = hgrn2_mixer(h, hgrn_w_in[j], lb_all[i], hgrn_norm_g[j], hgrn_w_out[j])
        elif m == 2:
            y = swa_mixer(h, swa_w_in[j], swa_sinks[j], swa_w_out[j])
        else:
            y = conv_mixer(h, conv_w_in[j], conv_w[j], conv_w_out[j])
        x = x + g1 * y
        h = rmsnorm(x, norm_g[i, 1]) * (1.0 + sc2) + sh2
        h2d = h.reshape(B * T, D)
        idx, w = route(h2d, router_w, router_bias)
        x = x + g2 * moe_ffn(h2d, idx, w, moe_w_gate[i], moe_w_up[i], moe_w_down[i]).reshape(B, T, D)
    return rmsnorm(x, final_norm_g)
```

```cpp
#include <hip/hip_runtime.h>
#include <stdint.h>

#define LAS __attribute__((address_space(3)))
typedef unsigned short bf16_t;
typedef short bf16x8 __attribute__((ext_vector_type(8)));
typedef float f32x4 __attribute__((ext_vector_type(4)));
typedef unsigned u32x2 __attribute__((ext_vector_type(2)));
typedef float f32x2_t __attribute__((ext_vector_type(2)));
typedef unsigned u32x4 __attribute__((ext_vector_type(4)));

constexpr int D = 1024, NB = 8, SEQ = 4096, M = NB * SEQ, DEPTH = 4;
constexpr int NE = 16, FF = 1024;
constexpr float EPS = 1e-6f;
constexpr int NT = 512, NWV = 8;
constexpr int RCAP = 32768;
constexpr int MAXSLOT = 69632;

constexpr size_t WS_CTL = 0;
constexpr size_t CTL_BYTES = 65536;
constexpr int CW_CNT = 4096;
constexpr size_t WS_MOD = WS_CTL + CTL_BYTES;
constexpr size_t WS_LB = WS_MOD + (size_t)4 * 8 * 6144 * 4;
constexpr size_t WS_TOKINFO = WS_LB + 4096;
constexpr size_t WS_RTOK = WS_TOKINFO + (size_t)M * 16;
constexpr size_t WS_H = WS_RTOK + (size_t)NE * RCAP * 4;
constexpr size_t WS_Z = WS_H + (size_t)M * D * 2;
constexpr size_t WS_O = WS_Z + (size_t)M * D * 2;
constexpr size_t WS_U = WS_O + (size_t)M * D * 2;
constexpr size_t U_BYTES = (size_t)272 << 20;
constexpr size_t WS_ACT = WS_U;
constexpr size_t WS_Y = WS_U + (size_t)MAXSLOT * FF * 2;
constexpr size_t WT_POOL_IN = WS_U + U_BYTES;
constexpr size_t WT_POOL_GRP = WT_POOL_IN + (size_t)1024 * 1024 * 2;
constexpr size_t WT_POOL_OUT = WT_POOL_GRP + (size_t)1024 * 256 * 2;
constexpr size_t WT_HGRN_IN = WT_POOL_OUT + (size_t)1024 * 1024 * 2;
constexpr size_t WT_HGRN_OUT = WT_HGRN_IN + (size_t)4096 * 1024 * 2;
constexpr size_t WT_SWA_IN = WT_HGRN_OUT + (size_t)1024 * 1024 * 2;
constexpr size_t WT_SWA_OUT = WT_SWA_IN + (size_t)1536 * 1024 * 2;
constexpr size_t WT_CONV_IN = WT_SWA_OUT + (size_t)1024 * 1024 * 2;
constexpr size_t WT_CONV_OUT = WT_CONV_IN + (size_t)3072 * 1024 * 2;
constexpr size_t WT_GU = WT_CONV_OUT + (size_t)1024 * 1024 * 2;
constexpr size_t WT_DN = WT_GU + (size_t)64 * 2048 * 1024;
constexpr size_t WT_POOL_W2 = WT_DN + (size_t)64 * 1024 * 1024;
constexpr size_t WS_XB = WT_POOL_W2 + (size_t)1024 * 1024 * 2;
constexpr size_t WS_END = WS_XB + (size_t)M * D * 2;

struct P {
    const float *x, *c, *ada_w, *ada_b, *norm_g, *final_norm_g;
    const float *pool_w_in, *pool_w_grp, *pool_scale, *pool_w_out;
    const float *hgrn_w_in, *hgrn_lb_logits, *hgrn_norm_g, *hgrn_w_out;
    const float *swa_w_in, *swa_sinks, *swa_w_out;
    const float *conv_w_in, *conv_w, *conv_w_out;
    const float *router_w, *router_bias, *moe_w_gate, *moe_w_up, *moe_w_down;
    float* X;
    unsigned char* ws;
};

__device__ __forceinline__ int otid() { int t = threadIdx.x; asm volatile("" : "+v"(t)); return t; }
__device__ __forceinline__ float bf2f(unsigned v) { return __uint_as_float(v << 16); }
__device__ __forceinline__ unsigned f2bf(float f) { unsigned u = __float_as_uint(f); return (u + 0x7fffu + ((u >> 16) & 1u)) >> 16; }
__device__ __forceinline__ unsigned pk2(float lo, float hi) { return f2bf(lo) | (f2bf(hi) << 16); }
__device__ __forceinline__ float bflo(unsigned w) { return __uint_as_float(w << 16); }
__device__ __forceinline__ float bfhi(unsigned w) { return __uint_as_float(w & 0xffff0000u); }
__device__ __forceinline__ float wave_sum(float v) {
#pragma unroll
    for (int o = 1; o < 64; o <<= 1) v += __shfl_xor(v, o);
    return v;
}
__device__ __forceinline__ float sigmoidf_(float x) { return 1.f / (1.f + __expf(-x)); }
__device__ __forceinline__ float siluf_(float x) { return x / (1.f + __expf(-x)); }

__device__ __forceinline__ float sat8(float v) { return __builtin_amdgcn_fmed3f(v, -448.f, 448.f); }
__device__ __forceinline__ unsigned pk8x4(float a, float b, float c, float d) { a = sat8(a); b = sat8(b); c = sat8(c); d = sat8(d); unsigned w = 0; w = __builtin_amdgcn_cvt_pk_fp8_f32(a, b, w, false); w = __builtin_amdgcn_cvt_pk_fp8_f32(c, d, w, true); return w; }
struct ExpGeo { int cnt[NE]; int tstart[NE + 1]; };
__device__ __forceinline__ void load_geo(unsigned* ctl, int layer, ExpGeo& g) {
    int acc = 0;
#pragma unroll
    for (int e = 0; e < NE; ++e) { const int c = (int)__hip_atomic_load(ctl + CW_CNT + (layer * 16 + e) * 64, __ATOMIC_RELAXED, __HIP_MEMORY_SCOPE_AGENT); g.cnt[e] = c; g.tstart[e] = acc; acc += (c + 255) >> 8; }
    g.tstart[NE] = acc;
}

__device__ __forceinline__ void phase_prep(const P& p, int bid, int nblk, float* lds) {
    float* cond = lds;
    float* red = lds + 8 * 1024;
    const int tid = otid(), wave = tid >> 6, lane = tid & 63;
    for (int i = tid; i < NB * D / 4; i += NT) { const f32x4 c4 = ((const f32x4*)p.c)[i]; f32x4 o; o.x = siluf_(c4.x); o.y = siluf_(c4.y); o.z = siluf_(c4.z); o.w = siluf_(c4.w); ((f32x4*)cond)[i] = o; }
    __syncthreads();
    float* mod = (float*)(p.ws + WS_MOD);
    const int nitems = DEPTH * (6 * D / 128);
    for (int it = nblk - 1 - bid; it < nitems; it += nblk) {
        const int l = it / 48, col = (it % 48) * 128 + 2 * lane;
        const float* w = p.ada_w + (size_t)l * D * 6 * D + (size_t)(wave * 128) * 6 * D + col;
        float a0[NB], a1[NB];
#pragma unroll
        for (int b = 0; b < NB; ++b) { a0[b] = 0.f; a1[b] = 0.f; }
        const float* cw = cond + wave * 128;
#pragma unroll 1
        for (int k0 = 0; k0 < 128; k0 += 8) {
            f32x2_t wv[8];
#pragma unroll
            for (int k = 0; k < 8; ++k) wv[k] = *(const f32x2_t*)(w + (size_t)(k0 + k) * 6 * D);
#pragma unroll
            for (int b = 0; b < NB; ++b) {
                const f32x4 c0 = *(const f32x4*)(cw + b * D + k0), c1 = *(const f32x4*)(cw + b * D + k0 + 4);
                a0[b] += (c0.x * wv[0].x + c0.y * wv[1].x) + (c0.z * wv[2].x + c0.w * wv[3].x) + (c1.x * wv[4].x + c1.y * wv[5].x) + (c1.z * wv[6].x + c1.w * wv[7].x);
                a1[b] += (c0.x * wv[0].y + c0.y * wv[1].y) + (c0.z * wv[2].y + c0.w * wv[3].y) + (c1.x * wv[4].y + c1.y * wv[5].y) + (c1.z * wv[6].y + c1.w * wv[7].y);
            }
        }
#pragma unroll
        for (int b = 0; b < NB; ++b) { f32x2_t v = {a0[b], a1[b]}; *(f32x2_t*)(red + (wave * NB + b) * 128 + 2 * lane) = v; }
        __syncthreads();
        {
            const int b = tid >> 6;
            f32x2_t s = {0.f, 0.f};
#pragma unroll
            for (int w2 = 0; w2 < NWV; ++w2) s += *(const f32x2_t*)(red + (w2 * NB + b) * 128 + 2 * lane);
            const f32x2_t bb = *(const f32x2_t*)(p.ada_b + (size_t)l * 6 * D + col);
            *(f32x2_t*)(mod + ((size_t)l * NB + b) * 6 * D + col) = s + bb;
        }
        __syncthreads();
    }
    if (bid == 0) {
        float* lb = (float*)(p.ws + WS_LB);
        for (int d = tid; d < D; d += NT) {
            const float a0 = p.hgrn_lb_logits[d], a1 = p.hgrn_lb_logits[D + d], a2 = p.hgrn_lb_logits[2 * D + d], a3 = p.hgrn_lb_logits[3 * D + d];
            const float mx = fmaxf(fmaxf(a0, a1), fmaxf(a2, a3));
            const float e0 = __expf(a0 - mx), e1 = __expf(a1 - mx), e2 = __expf(a2 - mx), e3 = __expf(a3 - mx);
            lb[d] = e1 / (e0 + e1 + e2 + e3);
        }
    }
}

template <int MODE>
__device__ __forceinline__ void phase_norm(const P& p, int layer, int bid, int nblk, float* lds, int cl = -1, bf16_t* Xo = nullptr) {
    (void)lds; (void)cl;
    bf16_t* Xb = (bf16_t*)(p.ws + WS_XB);
    if (!Xo) Xo = Xb;
    const int tid = otid(), wave = tid >> 6, lane = tid & 63;
    const int NGW = nblk * NWV, gw = bid * NWV + wave;
    const int RPW = M / NGW;
    const float* mod = (const float*)(p.ws + WS_MOD);
    unsigned* ctl = (unsigned*)(p.ws + WS_CTL);
    unsigned char* H = p.ws + WS_H;
    const unsigned char* Y8 = p.ws + WS_Y;
    const u32x4* tokinfo = (const u32x4*)(p.ws + WS_TOKINFO);
    const int row0 = gw * RPW, b = row0 / SEQ;
    const float* ng = (MODE == 2) ? p.final_norm_g : p.norm_g + (size_t)(layer * 2) * D;
#define NCOL(q) (((q) >> 1) * 512 + 8 * lane + 4 * ((q) & 1))
    f32x4 gv[4], g2v[4], scv[4], shv[4];
#pragma unroll
    for (int q = 0; q < 4; ++q) {
        gv[q] = *(const f32x4*)(ng + NCOL(q));
        if (MODE == 1 || MODE == 2) g2v[q] = *(const f32x4*)(mod + ((size_t)(layer - 1) * NB + b) * 6 * D + 5 * D + NCOL(q)) * 0.125f;
        if (MODE != 2) { const float* sh = mod + ((size_t)layer * NB + b) * 6 * D; shv[q] = *(const f32x4*)(sh + NCOL(q)); scv[q] = 1.f + *(const f32x4*)(sh + D + NCOL(q)); gv[q] = gv[q] * scv[q]; }
    }
    u32x4 ti_n = {0u, 0u, 0u, 0u};
    f32x4 vx[4]; unsigned y0[4], y1[4]; float w0 = 0.f, w1 = 0.f;
#define NORM_LOAD(R) do { const int r_ = (R); \
        if (MODE == 0) { _Pragma("unroll") for (int q = 0; q < 4; ++q) vx[q] = *(const f32x4*)(p.x + (size_t)r_ * D + NCOL(q)); } \
        else { _Pragma("unroll") for (int j = 0; j < 2; ++j) { const u32x4 q4 = *(const u32x4*)(Xb + (size_t)r_ * D + j * 512 + 8 * lane); \
            vx[2 * j] = (f32x4){bflo(q4.x), bfhi(q4.x), bflo(q4.y), bfhi(q4.y)}; vx[2 * j + 1] = (f32x4){bflo(q4.z), bfhi(q4.z), bflo(q4.w), bfhi(q4.w)}; } } \
        if (MODE == 1 || MODE == 2) { const u32x4 ti = ti_n; w0 = __uint_as_float(ti.z); w1 = __uint_as_float(ti.w); \
            _Pragma("unroll") for (int j = 0; j < 2; ++j) { const u32x2 ya = *(const u32x2*)(Y8 + (size_t)r_ * 2 * D + j * 512 + 8 * lane), yb = *(const u32x2*)(Y8 + (size_t)r_ * 2 * D + D + j * 512 + 8 * lane); \
                y0[2 * j] = ya.x; y0[2 * j + 1] = ya.y; y1[2 * j] = yb.x; y1[2 * j + 1] = yb.y; } \
            if (r_ + 1 < row0 + RPW) ti_n = tokinfo[r_ + 1]; } } while (0)
    if (MODE == 1 || MODE == 2) ti_n = tokinfo[row0];
    NORM_LOAD(row0);
    for (int row = row0; row < row0 + RPW; ++row) {
        f32x4 v[4];
#pragma unroll
        for (int j = 0; j < 4; ++j) {
            v[j] = vx[j];
            if (MODE == 1 || MODE == 2) {
                const f32x2_t a0 = __builtin_amdgcn_cvt_pk_f32_fp8(y0[j], false), a1 = __builtin_amdgcn_cvt_pk_f32_fp8(y0[j], true);
                const f32x2_t b0 = __builtin_amdgcn_cvt_pk_f32_fp8(y1[j], false), b1 = __builtin_amdgcn_cvt_pk_f32_fp8(y1[j], true);
                v[j].x += g2v[j].x * (w0 * a0.x + w1 * b0.x);
                v[j].y += g2v[j].y * (w0 * a0.y + w1 * b0.y);
                v[j].z += g2v[j].z * (w0 * a1.x + w1 * b1.x);
                v[j].w += g2v[j].w * (w0 * a1.y + w1 * b1.y);
            }
        }
        if (row + 1 < row0 + RPW) NORM_LOAD(row + 1);
        float ss = 0.f;
#pragma unroll
        for (int j = 0; j < 4; ++j) ss += (v[j].x * v[j].x + v[j].y * v[j].y) + (v[j].z * v[j].z + v[j].w * v[j].w);
        const float rstd = rsqrtf(wave_sum(ss) * (1.f / D) + EPS);
        if (MODE == 2) {
            float* o = ((Xo == Xb) ? p.X : (float*)Xo) + (size_t)row * D;
#pragma unroll
            for (int q = 0; q < 4; ++q) *(f32x4*)(o + NCOL(q)) = v[q] * rstd * gv[q];
        } else {
            bf16_t* o = Xo + (size_t)row * D;
#pragma unroll
            for (int j = 0; j < 2; ++j) {
                { u32x4 xw; xw.x = pk2(v[2 * j].x, v[2 * j].y); xw.y = pk2(v[2 * j].z, v[2 * j].w); xw.z = pk2(v[2 * j + 1].x, v[2 * j + 1].y); xw.w = pk2(v[2 * j + 1].z, v[2 * j + 1].w);
                  *(u32x4*)(o + j * 512 + 8 * lane) = xw; }
                const f32x4 h0 = v[2 * j] * rstd * gv[2 * j] + shv[2 * j], h1 = v[2 * j + 1] * rstd * gv[2 * j + 1] + shv[2 * j + 1];
                u32x2 w; w.x = pk8x4(h0.x, h0.y, h0.z, h0.w); w.y = pk8x4(h1.x, h1.y, h1.z, h1.w);
                *(u32x2*)(H + (size_t)row * D + j * 512 + 8 * lane) = w;
            }
        }
    }
#undef NCOL
#undef NORM_LOAD
}

constexpr int N3_WP = 0;
constexpr int N3_RED = 64 * 272;
constexpr int N3_BIAS = N3_RED + 512;
constexpr int N3_LG = N3_BIAS + 16;
constexpr int N3_WCNT = N3_LG + 8 * 272;
constexpr int N3_BBASE = N3_WCNT + 128;
__device__ __forceinline__ void phase_norm3(const P& p, int layer, int bid, int nblk, float* lds, int cl = -1) {
    if (cl < 0) cl = layer;
    const int tid = otid(), wave = tid >> 6, lane = tid & 63, m = lane & 15, kq = lane >> 4;
    const float* mod = (const float*)(p.ws + WS_MOD);
    unsigned* ctl = (unsigned*)(p.ws + WS_CTL);
    unsigned char* H8 = p.ws + WS_H;
    u32x4* tokinfo = (u32x4*)(p.ws + WS_TOKINFO);
    int* rtok = (int*)(p.ws + WS_RTOK);
    const float* ng = p.norm_g + (size_t)(layer * 2 + 1) * D;
    int* wcnt = (int*)(lds + N3_WCNT);
    int* bbase = (int*)(lds + N3_BBASE);
    float rb[NE];
#pragma unroll
    for (int e = 0; e < NE; ++e) rb[e] = p.router_bias[e];
    for (int grp = bid; grp < M / 128; grp += nblk) {
        const int b = (grp * 128) / SEQ;
        const float* sh = mod + ((size_t)layer * NB + b) * 6 * D + 3 * D;
        const float* sc = sh + D;
        {
            float bp[NE];
#pragma unroll
            for (int e = 0; e < NE; ++e) bp[e] = 0.f;
#pragma unroll
            for (int q = 0; q < 2; ++q) {
                const int c = tid + q * NT;
                const float gs = ng[c] * (1.f + sc[c]), shc = sh[c];
                const f32x4 r0 = *(const f32x4*)(p.router_w + c * NE), r1 = *(const f32x4*)(p.router_w + c * NE + 4), r2 = *(const f32x4*)(p.router_w + c * NE + 8), r3 = *(const f32x4*)(p.router_w + c * NE + 12);
                float* dst = lds + N3_WP + ((c >> 6) * 4 + ((c >> 2) & 3)) * 272 + (((c >> 4) & 3) * 4 + (c & 3)) * 16;
                *(f32x4*)(dst) = r0 * gs; *(f32x4*)(dst + 4) = r1 * gs; *(f32x4*)(dst + 8) = r2 * gs; *(f32x4*)(dst + 12) = r3 * gs;
                bp[0] += shc * r0.x; bp[1] += shc * r0.y; bp[2] += shc * r0.z; bp[3] += shc * r0.w; bp[4] += shc * r1.x; bp[5] += shc * r1.y; bp[6] += shc * r1.z; bp[7] += shc * r1.w;
                bp[8] += shc * r2.x; bp[9] += shc * r2.y; bp[10] += shc * r2.z; bp[11] += shc * r2.w; bp[12] += shc * r3.x; bp[13] += shc * r3.y; bp[14] += shc * r3.z; bp[15] += shc * r3.w;
            }
#pragma unroll
            for (int e = 0; e < NE; ++e) {
#pragma unroll
                for (int o = 1; o < 64; o <<= 1) bp[e] += __shfl_xor(bp[e], o);
            }
            if (lane == 0) {
#pragma unroll
                for (int e = 0; e < NE; ++e) lds[N3_RED + wave * 16 + e] = bp[e];
            }
        }
        __syncthreads();
        if (tid < NE) { float s = 0.f;
#pragma unroll
            for (int q = 0; q < NWV; ++q) s += lds[N3_RED + q * 16 + tid];
            lds[N3_BIAS + tid] = s; }
        __syncthreads();
        const int R0 = grp * 128 + wave * 16;
        const bf16_t* xr = (const bf16_t*)(p.ws + WS_XB) + (size_t)(R0 + m) * D + 4 * kq;
        f32x4 d0 = {0.f, 0.f, 0.f, 0.f}, d1 = {0.f, 0.f, 0.f, 0.f};
        float ss = 0.f;
#pragma unroll 2
        for (int ch = 0; ch < 16; ++ch) {
            f32x4 xv[4];
#pragma unroll
            for (int j = 0; j < 4; ++j) { const u32x2 q = *(const u32x2*)(xr + ch * 64 + 16 * j); xv[j] = (f32x4){bflo(q.x), bfhi(q.x), bflo(q.y), bfhi(q.y)}; }
            const float* wp = lds + N3_WP + (ch * 4 + kq) * 272 + m;
#pragma unroll
            for (int j = 0; j < 4; ++j) {
                ss += (xv[j].x * xv[j].x + xv[j].y * xv[j].y) + (xv[j].z * xv[j].z + xv[j].w * xv[j].w);
                d0 = __builtin_amdgcn_mfma_f32_16x16x4f32(xv[j].x, wp[(4 * j + 0) * 16], d0, 0, 0, 0);
                d1 = __builtin_amdgcn_mfma_f32_16x16x4f32(xv[j].y, wp[(4 * j + 1) * 16], d1, 0, 0, 0);
                d0 = __builtin_amdgcn_mfma_f32_16x16x4f32(xv[j].z, wp[(4 * j + 2) * 16], d0, 0, 0, 0);
                d1 = __builtin_amdgcn_mfma_f32_16x16x4f32(xv[j].w, wp[(4 * j + 3) * 16], d1, 0, 0, 0);
            }
        }
        ss += __shfl_xor(ss, 16); ss += __shfl_xor(ss, 32);
        const float rstd = rsqrtf(ss * (1.f / D) + EPS);
        {
            const f32x4 d = d0 + d1; const float be = lds[N3_BIAS + m];
            float* lg = lds + N3_LG + wave * 272;
#pragma unroll
            for (int i = 0; i < 4; ++i) { const float rs = __shfl(rstd, 4 * kq + i); lg[(4 * kq + i) * 17 + m] = rs * d[i] + be; }
        }
        asm volatile("s_waitcnt lgkmcnt(0)" ::: "memory");
        int my_e0 = -1, my_e1 = -1, my_row = -1; float my_w0 = 0.f, my_w1 = 0.f;
        {
            float lgt[NE];
            const float* lg = lds + N3_LG + wave * 272 + m * 17;
#pragma unroll
            for (int e = 0; e < NE; ++e) lgt[e] = lg[e];
                float sc_[NE], sel[NE];
#pragma unroll
                for (int e = 0; e < NE; ++e) { const float lg = lgt[e]; sc_[e] = sigmoidf_(lg); sel[e] = sc_[e] + rb[e]; }
                float gs[4];
#pragma unroll
                for (int g = 0; g < 4; ++g) {
                    const float a = sel[4 * g], b2 = sel[4 * g + 1], c2 = sel[4 * g + 2], d2 = sel[4 * g + 3];
                    const float hi1 = fmaxf(a, b2), lo1 = fminf(a, b2), hi2 = fmaxf(c2, d2), lo2 = fminf(c2, d2);
                    gs[g] = fmaxf(hi1, hi2) + fmaxf(fminf(hi1, hi2), fmaxf(lo1, lo2));
                }
                int best = 0; float bs = gs[0];
#pragma unroll
                for (int g = 1; g < 4; ++g) if (gs[g] > bs) { bs = gs[g]; best = g; }
                float s4[4], p4[4];
#pragma unroll
                for (int i = 0; i < 4; ++i) {
                    s4[i] = best == 0 ? sel[i] : best == 1 ? sel[4 + i] : best == 2 ? sel[8 + i] : sel[12 + i];
                    p4[i] = best == 0 ? sc_[i] : best == 1 ? sc_[4 + i] : best == 2 ? sc_[8 + i] : sc_[12 + i];
                }
                int i0 = 0; float m0 = s4[0], q0 = p4[0];
#pragma unroll
                for (int i = 1; i < 4; ++i) if (s4[i] > m0) { m0 = s4[i]; i0 = i; q0 = p4[i]; }
                int i1 = -1; float m1 = -INFINITY, q1 = 0.f;
#pragma unroll
                for (int i = 0; i < 4; ++i) if (i != i0 && s4[i] > m1) { m1 = s4[i]; i1 = i; q1 = p4[i]; }
            const float inv = 1.f / (q0 + q1);
            if (lane < 16) { my_e0 = best * 4 + i0; my_e1 = best * 4 + i1; my_w0 = q0 * inv; my_w1 = q1 * inv; my_row = R0 + lane; }
        }
        {
            f32x4 gsv[4], shv[4];
#pragma unroll
            for (int j = 0; j < 4; ++j) { const f32x4 g4 = *(const f32x4*)(ng + j * 256 + 4 * lane), s1 = *(const f32x4*)(sc + j * 256 + 4 * lane); gsv[j] = g4 * (1.f + s1); shv[j] = *(const f32x4*)(sh + j * 256 + 4 * lane); }
            const bf16_t* xq = (const bf16_t*)(p.ws + WS_XB) + (size_t)R0 * D;
            u32x2 qn[4];
#pragma unroll
            for (int j = 0; j < 4; ++j) qn[j] = *(const u32x2*)(xq + j * 256 + 4 * lane);
#pragma unroll 2
            for (int r = 0; r < 16; ++r) {
                const float rs = __shfl(rstd, r);
                u32x2 q[4];
#pragma unroll
                for (int j = 0; j < 4; ++j) q[j] = qn[j];
                if (r + 1 < 16) {
#pragma unroll
                    for (int j = 0; j < 4; ++j) qn[j] = *(const u32x2*)(xq + (size_t)(r + 1) * D + j * 256 + 4 * lane); }
#pragma unroll
                for (int j = 0; j < 4; ++j) { const f32x4 hq = (f32x4){bflo(q[j].x), bfhi(q[j].x), bflo(q[j].y), bfhi(q[j].y)} * rs * gsv[j] + shv[j];
                    const unsigned w = pk8x4(hq.x, hq.y, hq.z, hq.w);
                    *(unsigned*)(H8 + (size_t)(R0 + r) * D + j * 256 + 4 * lane) = w; }
            }
        }
        const unsigned long long lt = (1ull << lane) - 1ull;
        int mycount = 0;
#pragma unroll
        for (int e = 0; e < NE; ++e) {
            const unsigned long long m0 = __ballot(my_e0 == e), m1 = __ballot(my_e1 == e);
            const int c = __popcll(m0) + __popcll(m1);
            if (lane == e) mycount = c;
        }
        if (lane < NE) wcnt[wave * NE + lane] = mycount;
        __syncthreads();
        if (tid < NE) {
            int tot = 0;
#pragma unroll
            for (int w2 = 0; w2 < NWV; ++w2) tot += wcnt[w2 * NE + tid];
            bbase[tid] = (cl >= 8) ? 0 : (int)atomicAdd(ctl + CW_CNT + (cl * 16 + tid) * 64, (unsigned)tot);
        }
        __syncthreads();
        int pos0 = 0, pos1 = 0;
#pragma unroll
        for (int e = 0; e < NE; ++e) {
            int be = bbase[e];
            for (int w2 = 0; w2 < wave; ++w2) be += wcnt[w2 * NE + e];
            const unsigned long long m0 = __ballot(my_e0 == e), m1 = __ballot(my_e1 == e);
            if (my_e0 == e) pos0 = be + __popcll(m0 & lt);
            if (my_e1 == e) pos1 = be + __popcll(m0) + __popcll(m1 & lt);
        }
        if (my_row >= 0) {
            rtok[my_e0 * RCAP + pos0] = my_row * 2; rtok[my_e1 * RCAP + pos1] = my_row * 2 + 1;
            u32x4 ti; ti.x = ((unsigned)my_e0 << 16) | (unsigned)pos0; ti.y = ((unsigned)my_e1 << 16) | (unsigned)pos1; ti.z = __float_as_uint(my_w0); ti.w = __float_as_uint(my_w1);
            tokinfo[my_row] = ti;
        }
        __syncthreads();
    }
}

__device__ __forceinline__ void phase_pool(const P& p, int bid, int nblk) {
    const bf16_t* U0 = (const bf16_t*)(p.ws + WS_U);
    bf16_t* P0 = (bf16_t*)(p.ws + WS_U + ((size_t)64 << 20));
    const int nitem = 128 * (M / 32);
    for (int it = bid * NT + otid(); it < nitem; it += nblk * NT) {
        const int ch = it & 127, seg = it >> 7;
        const int col = ch * 8, g = col >> 8, w = 2 << g;
        const int t0 = seg * 32, tb = t0 & (SEQ - 1);
        float s[8];
#pragma unroll
        for (int i = 0; i < 8; ++i) s[i] = 0.f;
        for (int i = 1; i < w; ++i) if (tb - i >= 0) {
            const u32x4 v = *(const u32x4*)(U0 + (size_t)(t0 - i) * D + col);
            s[0] += bflo(v.x); s[1] += bfhi(v.x); s[2] += bflo(v.y); s[3] += bfhi(v.y); s[4] += bflo(v.z); s[5] += bfhi(v.z); s[6] += bflo(v.w); s[7] += bfhi(v.w);
        }
        const u32x4 zero4 = {0u, 0u, 0u, 0u};
        u32x4 vn = *(const u32x4*)(U0 + (size_t)t0 * D + col);
        u32x4 qn = (tb - w + 1 >= 0) ? *(const u32x4*)(U0 + (size_t)(t0 - w + 1) * D + col) : zero4;
        for (int r = 0; r < 32; ++r) {
            const int t = t0 + r, tp = tb + r;
            const u32x4 v = vn, q = qn;
            if (r + 1 < 32) { vn = *(const u32x4*)(U0 + (size_t)(t + 1) * D + col); qn = (tp + 2 - w >= 0) ? *(const u32x4*)(U0 + (size_t)(t + 2 - w) * D + col) : zero4; }
            float u[8] = {bflo(v.x), bfhi(v.x), bflo(v.y), bfhi(v.y), bflo(v.z), bfhi(v.z), bflo(v.w), bfhi(v.w)};
            const float inv = 1.f / (float)(tp + 1 < w ? tp + 1 : w);
            float o[8];
#pragma unroll
            for (int i = 0; i < 8; ++i) { s[i] += u[i]; o[i] = s[i] * inv - u[i]; }
            u32x4 ov; ov.x = pk2(o[0], o[1]); ov.y = pk2(o[2], o[3]); ov.z = pk2(o[4], o[5]); ov.w = pk2(o[6], o[7]);
            *(u32x4*)(P0 + (size_t)t * D + col) = ov;
            s[0] -= bflo(q.x); s[1] -= bfhi(q.x); s[2] -= bflo(q.y); s[3] -= bfhi(q.y); s[4] -= bflo(q.z); s[5] -= bfhi(q.z); s[6] -= bflo(q.w); s[7] -= bfhi(q.w);
        }
    }
}

__device__ __forceinline__ void phase_hgrn_gate(const P& p, int bid, int nblk) {
    const int tid = otid(), wave = tid >> 6, lane = tid & 63;
    const int NGW = nblk * NWV, RPW = M / NGW, row0 = (bid * NWV + wave) * RPW;
    const bf16_t* O = (const bf16_t*)(p.ws + WS_O);
    const bf16_t* U1 = (const bf16_t*)(p.ws + WS_U);
    unsigned char* Z = p.ws + WS_Z;
    float ngv[16];
#pragma unroll
    for (int i = 0; i < 16; ++i) ngv[i] = p.hgrn_norm_g[(lane & 7) * 16 + i];
    u32x4 a0, a1, g0, g1;
#define GATE_LOAD(R) do { const size_t r_ = (size_t)(R); a0 = *(const u32x4*)(O + r_ * D + lane * 16); a1 = *(const u32x4*)(O + r_ * D + lane * 16 + 8); \
        g0 = *(const u32x4*)(U1 + r_ * 4096 + 3072 + lane * 16); g1 = *(const u32x4*)(U1 + r_ * 4096 + 3072 + lane * 16 + 8); } while (0)
    GATE_LOAD(row0);
    for (int row = row0; row < row0 + RPW; ++row) {
        float o[16] = {bflo(a0.x), bfhi(a0.x), bflo(a0.y), bfhi(a0.y), bflo(a0.z), bfhi(a0.z), bflo(a0.w), bfhi(a0.w),
                       bflo(a1.x), bfhi(a1.x), bflo(a1.y), bfhi(a1.y), bflo(a1.z), bfhi(a1.z), bflo(a1.w), bfhi(a1.w)};
        float sg[16] = {bflo(g0.x), bfhi(g0.x), bflo(g0.y), bfhi(g0.y), bflo(g0.z), bfhi(g0.z), bflo(g0.w), bfhi(g0.w),
                        bflo(g1.x), bfhi(g1.x), bflo(g1.y), bfhi(g1.y), bflo(g1.z), bfhi(g1.z), bflo(g1.w), bfhi(g1.w)};
        if (row + 1 < row0 + RPW) GATE_LOAD(row + 1);
        float ss = 0.f;
#pragma unroll
        for (int i = 0; i < 16; ++i) ss += o[i] * o[i];
        ss += __shfl_xor(ss, 1); ss += __shfl_xor(ss, 2); ss += __shfl_xor(ss, 4);
        const float rstd = rsqrtf(ss * (1.f / 128.f) + EPS);
        float z[16];
#pragma unroll
        for (int i = 0; i < 16; ++i) z[i] = o[i] * (rstd * 8.f) * ngv[i] * sg[i];
        u32x4 z0; z0.x = pk8x4(z[0], z[1], z[2], z[3]); z0.y = pk8x4(z[4], z[5], z[6], z[7]); z0.z = pk8x4(z[8], z[9], z[10], z[11]); z0.w = pk8x4(z[12], z[13], z[14], z[15]);
        *(u32x4*)(Z + (size_t)row * D + lane * 16) = z0;
    }
#undef GATE_LOAD
}

__device__ __forceinline__ void phase_conv(const P& p, int bid, int nblk) {
    const bf16_t* Bg = (const bf16_t*)(p.ws + WS_U);
    const bf16_t* CU = (const bf16_t*)(p.ws + WS_U + ((size_t)64 << 20));
    unsigned char* Z = p.ws + WS_Z;
    const int nitem = M * 128, step = nblk * NT;
    int it = bid * NT + otid();
    if (it >= nitem) return;
    const int col = (it & 127) * 8;
    f32x4 cw[3][2];
#pragma unroll
    for (int j = 0; j < 3; ++j) { cw[j][0] = *(const f32x4*)(p.conv_w + j * D + col); cw[j][1] = *(const f32x4*)(p.conv_w + j * D + col + 4); }
    u32x4 c0, c1, c2, bv;
#define CONV_LOAD(IT) do { const int t_ = (IT) >> 7, tp_ = t_ & (SEQ - 1); const u32x4 z_ = {0u, 0u, 0u, 0u}; \
        c0 = (tp_ >= 2) ? *(const u32x4*)(CU + (size_t)(t_ - 2) * D + col) : z_; c1 = (tp_ >= 1) ? *(const u32x4*)(CU + (size_t)(t_ - 1) * D + col) : z_; \
        c2 = *(const u32x4*)(CU + (size_t)t_ * D + col); bv = *(const u32x4*)(Bg + (size_t)t_ * D + col); } while (0)
    CONV_LOAD(it);
    for (;;) {
        const u32x4 a0 = c0, a1 = c1, a2 = c2, ab = bv; const int t = it >> 7;
        const int nx = it + step; const bool more = nx < nitem;
        if (more) CONV_LOAD(nx);
        float acc[8];
        acc[0] = cw[0][0].x * bflo(a0.x) + cw[1][0].x * bflo(a1.x) + cw[2][0].x * bflo(a2.x); acc[1] = cw[0][0].y * bfhi(a0.x) + cw[1][0].y * bfhi(a1.x) + cw[2][0].y * bfhi(a2.x);
        acc[2] = cw[0][0].z * bflo(a0.y) + cw[1][0].z * bflo(a1.y) + cw[2][0].z * bflo(a2.y); acc[3] = cw[0][0].w * bfhi(a0.y) + cw[1][0].w * bfhi(a1.y) + cw[2][0].w * bfhi(a2.y);
        acc[4] = cw[0][1].x * bflo(a0.z) + cw[1][1].x * bflo(a1.z) + cw[2][1].x * bflo(a2.z); acc[5] = cw[0][1].y * bfhi(a0.z) + cw[1][1].y * bfhi(a1.z) + cw[2][1].y * bfhi(a2.z);
        acc[6] = cw[0][1].z * bflo(a0.w) + cw[1][1].z * bflo(a1.w) + cw[2][1].z * bflo(a2.w); acc[7] = cw[0][1].w * bfhi(a0.w) + cw[1][1].w * bfhi(a1.w) + cw[2][1].w * bfhi(a2.w);
        u32x2 o; o.x = pk8x4(acc[0] * bflo(ab.x) * 8.f, acc[1] * bfhi(ab.x) * 8.f, acc[2] * bflo(ab.y) * 8.f, acc[3] * bfhi(ab.y) * 8.f);
        o.y = pk8x4(acc[4] * bflo(ab.z) * 8.f, acc[5] * bfhi(ab.z) * 8.f, acc[6] * bflo(ab.w) * 8.f, acc[7] * bfhi(ab.w) * 8.f);
        *(u32x2*)(Z + (size_t)t * D + col) = o;
        if (!more) break;
        it = nx;
    }
#undef CONV_LOAD
}

namespace pg8 {
constexpr int BM = 256, BK = 64, HALF = 128, HTB = HALF * BK * 2, STAGE_BYTES = 8 * HTB;
__device__ __forceinline__ int lds_byte(int r, int c) { const int st = (r >> 4) * 2 + (c >> 5), rr = r & 15, cc = c & 31, ob = rr * 64 + cc * 2; return st * 1024 + (ob ^ (((ob >> 9) & 1) << 5)); }
__device__ __forceinline__ void stage_rc(int b, int& R, int& C) { const int st = b / 1024, sb = b % 1024, swz = sb ^ (((sb >> 9) & 1) << 5); R = (st >> 1) * 16 + swz / 64; C = (st & 1) * 32 + (swz % 64) / 2; }
__device__ __forceinline__ int perm32(int rho) { const int n = rho >> 4, i = rho & 15; return 8 * (i >> 2) + 4 * n + (i & 3); }
struct Unit { int pm, pn, e, ui; };
typedef f32x4 Acc[2][2][4][2];

struct DenseProb {
    static constexpr int esz = 2;
    const bf16_t* A; const bf16_t* Bt; int lda, ldb, acol_pn, nM, nN, G, c;
    __device__ __forceinline__ bool next(int i, Unit& u) const { const int l = i * (G >> 3) + (c >> 3), rr = l / nN; u.pn = l - rr * nN; u.pm = rr * 8 + (c & 7); u.e = 0; u.ui = i; return u.pm < nM; }
    __device__ __forceinline__ void a_off(const Unit& u, const int (&R)[2], const int (&C)[2], unsigned (&off)[2][2]) const {
#pragma unroll
        for (int h = 0; h < 2; ++h)
#pragma unroll
            for (int i = 0; i < 2; ++i) off[h][i] = (unsigned)((u.pm * 256 + h * 128 + R[i]) * lda + u.pn * acol_pn + C[i]) * 2u;
    }
    __device__ __forceinline__ const char* a_base() const { return (const char*)A; }
    __device__ __forceinline__ const char* b_base(const Unit& u) const { return (const char*)Bt + (size_t)u.pn * 256 * ldb * 2; }
};
struct DenseProb8 {
    static constexpr int esz = 1;
    const unsigned char* A; const unsigned char* Bt; int lda, ldb, nM, nN, G, c, sa, sb;
    __device__ __forceinline__ bool next(int i, Unit& u) const { const int l = i * (G >> 3) + (c >> 3), rr = l / nN; u.pn = l - rr * nN; u.pm = rr * 8 + (c & 7); u.e = 0; u.ui = i; return u.pm < nM; }
    __device__ __forceinline__ void a_off(const Unit& u, const int (&R)[2], const int (&C)[2], unsigned (&off)[2][2]) const {
#pragma unroll
        for (int h = 0; h < 2; ++h)
#pragma unroll
            for (int i = 0; i < 2; ++i) off[h][i] = (unsigned)((u.pm * 256 + h * 128 + R[i]) * lda + 2 * C[i]);
    }
    __device__ __forceinline__ const char* a_base() const { return (const char*)A; }
    __device__ __forceinline__ const char* b_base(const Unit& u) const { return (const char*)Bt + (size_t)u.pn * 256 * ldb; }
};
struct MoeProb {
    static constexpr int esz = 1;
    const unsigned char* A; const unsigned char* Bt; size_t bstride; const int* rtok; const LAS int* geo; const LAS unsigned* rowtab; int lda, ldb, nN, G, c, gather, sa, sb;
    __device__ __forceinline__ bool next(int i, Unit& u) const {
        const int RT = geo[NE], npx = (RT + 7) >> 3;
        const int l = i * (G >> 3) + (c >> 3), rr = l / nN; u.pn = l - rr * nN; u.pm = (c & 7) * npx + rr; u.ui = i;
        int e = 0;
#pragma unroll
        for (int k = 1; k < NE; ++k) e += (u.pm >= geo[k]) ? 1 : 0;
        u.e = e; return rr < npx && u.pm < RT;
    }
    template <int SCAT, int NU> __device__ __forceinline__ void fill_rowtab(LAS unsigned* tab, int tid) const {
        if (tid < 256) {
            int tok[NU];
#pragma unroll
            for (int i = 0; i < NU; ++i) { Unit u; const bool ok = next(i, u); const int pos = (u.pm - geo[u.e]) * 256 + tid, cnt = geo[NE + 1 + u.e]; tok[i] = (ok && pos < cnt) ? rtok[u.e * RCAP + pos] : (SCAT ? 2 * M + tid : 0); }
#pragma unroll
            for (int i = 0; i < NU; ++i) tab[i * 256 + tid] = SCAT ? (unsigned)tok[i] * (unsigned)D : (unsigned)((tok[i] >> 1) * lda);
        }
    }
    __device__ __forceinline__ void a_off(const Unit& u, const int (&R)[2], const int (&C)[2], unsigned (&off)[2][2]) const {
        if (gather) {
#pragma unroll
            for (int h = 0; h < 2; ++h)
#pragma unroll
                for (int i = 0; i < 2; ++i) off[h][i] = rowtab[u.ui * 256 + h * 128 + R[i]] + (unsigned)(2 * C[i]);
        } else {
#pragma unroll
            for (int h = 0; h < 2; ++h)
#pragma unroll
                for (int i = 0; i < 2; ++i) off[h][i] = (unsigned)((u.pm * 256 + h * 128 + R[i]) * lda + 2 * C[i]);
        }
    }
    __device__ __forceinline__ const char* a_base() const { return (const char*)A; }
    __device__ __forceinline__ const char* b_base(const Unit& u) const { return (const char*)Bt + ((size_t)u.e * bstride + (size_t)u.pn * 256 * ldb); }
};

__device__ __forceinline__ unsigned cvt_pk_bf16(float lo, float hi) { unsigned r; asm volatile("v_cvt_pk_bf16_f32 %0, %1, %2" : "=v"(r) : "v"(lo), "v"(hi)); return r; }
__device__ __forceinline__ u32x4 pack8(const f32x4 v0, const f32x4 v1) { u32x4 w; w.x = cvt_pk_bf16(v0[0], v0[1]); w.y = cvt_pk_bf16(v0[2], v0[3]); w.z = cvt_pk_bf16(v1[0], v1[1]); w.w = cvt_pk_bf16(v1[2], v1[3]); return w; }
__device__ __forceinline__ float sigm(float x) { return __builtin_amdgcn_rcpf(1.f + __expf(-x)); }
__device__ __forceinline__ f32x4 silu4(f32x4 v) { f32x4 o; o[0] = v[0] * sigm(v[0]); o[1] = v[1] * sigm(v[1]); o[2] = v[2] * sigm(v[2]); o[3] = v[3] * sigm(v[3]); return o; }

__device__ __forceinline__ unsigned pk_fp8x4(float a, float b, float c, float d) { return pk8x4(a, b, c, d); }
#define ST16(ptr, val) (*(u32x4*)(ptr) = (val))
struct EpPlain { static constexpr bool PERM = true; static constexpr int NST = 16; bf16_t* C; const float* colscale; int ldc; float s0; int s0_pn; float s1;
    __device__ __forceinline__ void operator()(const Acc& acc, const Unit& u, int wr, int wc, int fr, int fq) const {
        const int row0 = u.pm * BM + wr * 64 + fr, col0 = u.pn * BM + wc * 32 + 8 * fq;
        const float sc = (u.pn < s0_pn) ? s0 : s1;
        f32x4 cs[2][2];
#pragma unroll
        for (int bj = 0; bj < 2; ++bj)
#pragma unroll
            for (int n = 0; n < 2; ++n) cs[bj][n] = colscale ? *(const f32x4*)(colscale + col0 + bj * HALF + 4 * n) * sc : (f32x4){sc, sc, sc, sc};
#pragma unroll
        for (int ai = 0; ai < 2; ++ai)
#pragma unroll
            for (int m = 0; m < 4; ++m) { bf16_t* rowp = C + (size_t)(row0 + ai * HALF + m * 16) * ldc + col0;
#pragma unroll
                for (int bj = 0; bj < 2; ++bj) ST16(rowp + bj * HALF, pack8(acc[ai][bj][m][0] * cs[bj][0], acc[ai][bj][m][1] * cs[bj][1])); }
    }
};
struct EpHgrnIn { static constexpr bool PERM = true; static constexpr int NST = 16; bf16_t* C; const float* lb;
    __device__ __forceinline__ void operator()(const Acc& acc, const Unit& u, int wr, int wc, int fr, int fq) const {
        const int row0 = u.pm * BM + wr * 64 + fr, col0 = u.pn * BM + wc * 32 + 8 * fq, kind = u.pn >> 2;
        f32x4 om[2][2];
#pragma unroll
        for (int bj = 0; bj < 2; ++bj)
#pragma unroll
            for (int n = 0; n < 2; ++n) om[bj][n] = (kind == 1) ? (1.f - *(const f32x4*)(lb + (col0 - 1024) + bj * HALF + 4 * n)) : (f32x4){0.f, 0.f, 0.f, 0.f};
#pragma unroll
        for (int ai = 0; ai < 2; ++ai)
#pragma unroll
            for (int m = 0; m < 4; ++m) { bf16_t* rowp = C + (size_t)(row0 + ai * HALF + m * 16) * 4096 + col0;
#pragma unroll
                for (int bj = 0; bj < 2; ++bj) { f32x4 v0 = acc[ai][bj][m][0] * 0.03125f, v1 = acc[ai][bj][m][1] * 0.03125f;
                    if (kind == 0 || kind == 3) { v0 = silu4(v0); v1 = silu4(v1); }
                    else if (kind == 1) { f32x4 a, b; a[0] = sigm(-v0[0]); a[1] = sigm(-v0[1]); a[2] = sigm(-v0[2]); a[3] = sigm(-v0[3]); b[0] = sigm(-v1[0]); b[1] = sigm(-v1[1]); b[2] = sigm(-v1[2]); b[3] = sigm(-v1[3]);
                        v0 = a * om[bj][0]; v1 = b * om[bj][1]; }
                    ST16(rowp + bj * HALF, pack8(v0, v1)); } }
    }
};
struct EpConvIn { static constexpr bool PERM = true; static constexpr int NST = 8; bf16_t* Bg; bf16_t* CU;
    __device__ __forceinline__ void operator()(const Acc& acc, const Unit& u, int wr, int wc, int fr, int fq) const {
        const int row0 = u.pm * BM + wr * 64 + fr;
        if (u.pn < 4) {
            const int col0 = u.pn * BM + wc * 32 + 8 * fq;
#pragma unroll
            for (int ai = 0; ai < 2; ++ai)
#pragma unroll
                for (int m = 0; m < 4; ++m) { bf16_t* rowp = Bg + (size_t)(row0 + ai * HALF + m * 16) * D + col0;
#pragma unroll
                    for (int bj = 0; bj < 2; ++bj) ST16(rowp + bj * HALF, pack8(acc[ai][bj][m][0] * 0.03125f, acc[ai][bj][m][1] * 0.03125f)); }
        } else {
            const int col0 = (u.pn - 4) * HALF + wc * 32 + 8 * fq;
#pragma unroll
            for (int ai = 0; ai < 2; ++ai)
#pragma unroll
                for (int m = 0; m < 4; ++m) ST16(CU + (size_t)(row0 + ai * HALF + m * 16) * D + col0, pack8(acc[ai][0][m][0] * acc[ai][1][m][0] * (1.f / 1024.f), acc[ai][0][m][1] * acc[ai][1][m][1] * (1.f / 1024.f)));
        }
    }
};
struct EpSwiGlu { static constexpr bool PERM = true; static constexpr int NST = 4; unsigned char* ACT;
    __device__ __forceinline__ void operator()(const Acc& acc, const Unit& u, int wr, int wc, int fr, int fq) const {
        const int row0 = u.pm * BM + wr * 64 + fr + (fq & 1) * 16, col0 = u.pn * HALF + wc * 32 + 8 * (fq & 2);
#pragma unroll
        for (int ai = 0; ai < 2; ++ai)
#pragma unroll
            for (int mp = 0; mp < 2; ++mp) {
                u32x2 w[2];
#pragma unroll
                for (int q = 0; q < 2; ++q) { const int m = 2 * mp + q;
                    const f32x4 v0 = silu4(acc[ai][0][m][0] * 0.03125f) * acc[ai][1][m][0] * 0.25f, v1 = silu4(acc[ai][0][m][1] * 0.03125f) * acc[ai][1][m][1] * 0.25f;
                    w[q].x = pk_fp8x4(v0[0], v0[1], v0[2], v0[3]); w[q].y = pk_fp8x4(v1[0], v1[1], v1[2], v1[3]); }
                const auto rx = __builtin_amdgcn_permlane16_swap(w[0].x, w[1].x, false, false), ry = __builtin_amdgcn_permlane16_swap(w[0].y, w[1].y, false, false);
                u32x4 o; o.x = rx[0]; o.y = ry[0]; o.z = rx[1]; o.w = ry[1];
                *(u32x4*)(ACT + (size_t)(row0 + ai * HALF + mp * 32) * FF + col0) = o; }
    }
};
struct EpY8 { static constexpr bool PERM = true; static constexpr int NST = 8; unsigned char* Y; const LAS unsigned* rowtab;
    __device__ __forceinline__ void operator()(const Acc& acc, const Unit& u, int wr, int wc, int fr, int fq) const {
        const int col0 = u.pn * BM + wc * 32 + 8 * (fq & 2) + (fq & 1) * HALF;
        unsigned ro[2][4];
#pragma unroll
        for (int ai = 0; ai < 2; ++ai)
#pragma unroll
            for (int m = 0; m < 4; ++m) ro[ai][m] = rowtab[u.ui * 256 + ai * HALF + wr * 64 + m * 16 + fr];
#pragma unroll
        for (int ai = 0; ai < 2; ++ai)
#pragma unroll
            for (int m = 0; m < 4; ++m) {
                u32x2 w[2];
#pragma unroll
                for (int bj = 0; bj < 2; ++bj) { const f32x4 v0 = acc[ai][bj][m][0] * 0.03125f, v1 = acc[ai][bj][m][1] * 0.03125f;
                    w[bj].x = pk_fp8x4(v0[0], v0[1], v0[2], v0[3]); w[bj].y = pk_fp8x4(v1[0], v1[1], v1[2], v1[3]); }
                const auto rx = __builtin_amdgcn_permlane16_swap(w[0].x, w[1].x, false, false), ry = __builtin_amdgcn_permlane16_swap(w[0].y, w[1].y, false, false);
                u32x4 o; o.x = rx[0]; o.y = ry[0]; o.z = rx[1]; o.w = ry[1];
                *(u32x4*)(Y + (size_t)ro[ai][m] + col0) = o; }
    }
};
struct EpResid { static constexpr bool PERM = true; static constexpr int NST = 16; const bf16_t* X; const float* g1; bf16_t* Xo; float s; int pad_;
    __device__ __forceinline__ void operator()(const Acc& acc, const Unit& u, int wr, int wc, int fr, int fq) const {
        const int row0 = u.pm * BM + wr * 64 + fr, col0 = u.pn * BM + wc * 32 + 8 * fq;
        const float* gb = g1 + (size_t)(u.pm >> 4) * 6 * D;
        f32x4 gv[2][2];
#pragma unroll
        for (int bj = 0; bj < 2; ++bj)
#pragma unroll
            for (int n = 0; n < 2; ++n) gv[bj][n] = *(const f32x4*)(gb + col0 + bj * HALF + 4 * n) * s;
        u32x4 xn[2];
        { const size_t ro = (size_t)row0 * D + col0; xn[0] = *(const u32x4*)(X + ro); xn[1] = *(const u32x4*)(X + ro + HALF); }
#pragma unroll
        for (int q = 0; q < 8; ++q) {
            const int ai = q >> 2, m = q & 3;
            const size_t ro = (size_t)(row0 + ai * HALF + m * 16) * D + col0;
            const u32x4 xq0 = xn[0], xq1 = xn[1];
            if (q + 1 < 8) { const size_t rn = (size_t)(row0 + ((q + 1) >> 2) * HALF + ((q + 1) & 3) * 16) * D + col0; xn[0] = *(const u32x4*)(X + rn); xn[1] = *(const u32x4*)(X + rn + HALF); }
#pragma unroll
            for (int bj = 0; bj < 2; ++bj) { const u32x4 xq = bj ? xq1 : xq0;
                f32x4 x0 = {__uint_as_float(xq.x << 16), __uint_as_float(xq.x & 0xffff0000u), __uint_as_float(xq.y << 16), __uint_as_float(xq.y & 0xffff0000u)};
                f32x4 x1 = {__uint_as_float(xq.z << 16), __uint_as_float(xq.z & 0xffff0000u), __uint_as_float(xq.w << 16), __uint_as_float(xq.w & 0xffff0000u)};
                ST16(Xo + ro + bj * HALF, pack8(x0 + gv[bj][0] * acc[ai][bj][m][0], x1 + gv[bj][1] * acc[ai][bj][m][1])); }
            asm volatile("" ::: "memory");
        }
    }
};

typedef int i32x4v __attribute__((ext_vector_type(4)));
typedef int i32x8v __attribute__((ext_vector_type(8)));
template <class P_> __device__ __forceinline__ int prob_sa(const P_& S) { if constexpr (P_::esz == 1) return S.sa; else return 127; }
template <class P_> __device__ __forceinline__ int prob_sb(const P_& S) { if constexpr (P_::esz == 1) return S.sb; else return 127; }

__device__ __forceinline__ void glds16s(const void* sbase, unsigned voff, unsigned lds_dst) {
    unsigned keep;
    asm volatile("s_mov_b32 %0, m0\n\ts_mov_b32 m0, %3\n\ts_nop 0\n\tglobal_load_lds_dwordx4 %1, %2\n\ts_mov_b32 m0, %0"
                 : "=&s"(keep) : "v"(voff), "s"(sbase), "s"(lds_dst) : "memory");
}
__device__ __forceinline__ const char* uniform_ptr(const char* p) {
    const unsigned long long v = (unsigned long long)p;
    const unsigned lo = __builtin_amdgcn_readfirstlane((unsigned)v), hi = __builtin_amdgcn_readfirstlane((unsigned)(v >> 32));
    return (const char*)(((unsigned long long)hi << 32) | lo);
}

template <class Epi, class Prob>
__device__ __forceinline__ void gemm_phase(LAS unsigned char* lds, const Prob& S, const Epi& E, const int K) {
    int tid_ = threadIdx.x; asm volatile("" : "+v"(tid_));
    const int tid = tid_, wid = __builtin_amdgcn_readfirstlane(tid >> 6), lane = tid & 63, wr = wid >> 2, wc = wid & 3, fr = lane & 15, fq = lane >> 4;
    const int nt = K * Prob::esz / (BK * 2);
    int R[2], C[2]; unsigned voffB[2];
#pragma unroll
    for (int i = 0; i < 2; ++i) { stage_rc(tid * 16 + i * 8192, R[i], C[i]); const int Rb = Epi::PERM ? ((R[i] & ~31) + perm32(R[i] & 31)) : R[i]; voffB[i] = (unsigned)(Rb * S.ldb * Prob::esz + 2 * C[i]); }
    const size_t kstep = (size_t)(BK * 2);
    const int sclA = prob_sa(S), sclB = prob_sb(S); (void)sclA; (void)sclB;
    const size_t hstepB = (size_t)HALF * S.ldb * Prob::esz;
    const unsigned ldsw = (unsigned)wid * 1024u;
    const unsigned ldsbase = __builtin_amdgcn_readfirstlane((unsigned)(size_t)lds);
    const int aoff = lds_byte(wr * 64 + fr, fq * 8), boff = lds_byte(wc * 32 + fr, fq * 8);
#define PG8_SA(b, h) (((b) * 2 + (h)) * HTB)
#define PG8_SB(b, h) ((4 + (b) * 2 + (h)) * HTB)
#define PG8_STAGE(bufoff, gbase, voff) do { _Pragma("unroll") for (int _i = 0; _i < 2; ++_i) glds16s((gbase), (voff)[_i], ldsbase + (unsigned)(bufoff) + ldsw + (unsigned)(_i * 8192)); } while (0)
#define PG8_LDA(dst, b, h) do { if constexpr (Prob::esz == 2) { _Pragma("unroll") for (int m = 0; m < 4; ++m) _Pragma("unroll") for (int k = 0; k < 2; ++k) dst[m][k] = *(const LAS bf16x8*)(lds + PG8_SA(b, h) + aoff + m * 2048 + k * 1024); } \
        else { _Pragma("unroll") for (int m = 0; m < 4; ++m) { const i32x4v lo_ = *(const LAS i32x4v*)(lds + PG8_SA(b, h) + aoff + m * 2048), hi_ = *(const LAS i32x4v*)(lds + PG8_SA(b, h) + aoff + m * 2048 + 1024); dst##8[m] = __builtin_shufflevector(lo_, hi_, 0, 1, 2, 3, 4, 5, 6, 7); } } } while (0)
#define PG8_LDB(dst, b, h) do { if constexpr (Prob::esz == 2) { _Pragma("unroll") for (int n = 0; n < 2; ++n) _Pragma("unroll") for (int k = 0; k < 2; ++k) dst[n][k] = *(const LAS bf16x8*)(lds + PG8_SB(b, h) + boff + n * 2048 + k * 1024); } \
        else { _Pragma("unroll") for (int n = 0; n < 2; ++n) { const i32x4v lo_ = *(const LAS i32x4v*)(lds + PG8_SB(b, h) + boff + n * 2048), hi_ = *(const LAS i32x4v*)(lds + PG8_SB(b, h) + boff + n * 2048 + 1024); dst##8[n] = __builtin_shufflevector(lo_, hi_, 0, 1, 2, 3, 4, 5, 6, 7); } } } while (0)
#define PG8_MMA(ai, bj, At, Bt) do { __builtin_amdgcn_s_setprio(1); _Pragma("unroll") for (int m = 0; m < 4; ++m) _Pragma("unroll") for (int n = 0; n < 2; ++n) { \
        if constexpr (Prob::esz == 2) { _Pragma("unroll") for (int k = 0; k < 2; ++k) acc[ai][bj][m][n] = __builtin_amdgcn_mfma_f32_16x16x32_bf16(Bt[n][k], At[m][k], acc[ai][bj][m][n], 0, 0, 0); } \
        else asm volatile("v_mfma_f32_16x16x128_f8f6f4 %0, %1, %2, %0" : "+v"(acc[ai][bj][m][n]) : "v"(Bt##8[n]), "v"(At##8[m])); } \
        __builtin_amdgcn_s_setprio(0); } while (0)
#define PG8_WAIT_V(n) asm volatile("s_waitcnt vmcnt(" #n ")" ::: "memory")
#define PG8_WAIT_VF() do { if (fresh) asm volatile("s_waitcnt vmcnt(%0)" :: "n"(Epi::NST + 8) : "memory"); else asm volatile("s_waitcnt vmcnt(8)" ::: "memory"); } while (0)
#define PG8_WAIT_L(n) asm volatile("s_waitcnt lgkmcnt(" #n ")" ::: "memory")
#define PG8_BAR __builtin_amdgcn_s_barrier()
#define PG8_SCHED __builtin_amdgcn_sched_barrier(0)
    Unit cur, nxt; int ui = 0;
    if (!S.next(0, cur)) return;
    Acc acc;
#pragma unroll
    for (int a = 0; a < 2; ++a)
#pragma unroll
        for (int b = 0; b < 2; ++b)
#pragma unroll
            for (int m = 0; m < 4; ++m)
#pragma unroll
                for (int n = 0; n < 2; ++n) acc[a][b][m][n] = (f32x4){0.f, 0.f, 0.f, 0.f};
    bf16x8 At[4][2], B0[2][2], B1[2][2];
    i32x8v At8[4], B08[2], B18[2];
    (void)At; (void)B0; (void)B1; (void)At8; (void)B08; (void)B18;
    unsigned offA[2][2], noffA[2][2];
    S.a_off(cur, R, C, offA);
    const char* const Ab = uniform_ptr(S.a_base());
    const char* cB = uniform_ptr(S.b_base(cur));
    PG8_STAGE(PG8_SB(0, 0), cB, voffB); PG8_STAGE(PG8_SB(0, 1), cB + hstepB, voffB); PG8_STAGE(PG8_SA(0, 0), Ab, offA[0]); PG8_STAGE(PG8_SA(0, 1), Ab, offA[1]);
    if (wr == 1) PG8_BAR;
    PG8_WAIT_V(2); PG8_BAR;
    PG8_STAGE(PG8_SB(1, 0), cB + kstep, voffB); PG8_STAGE(PG8_SA(1, 0), Ab + kstep, offA[0]); PG8_STAGE(PG8_SB(1, 1), cB + hstepB + kstep, voffB);
    PG8_WAIT_V(6); PG8_BAR;
    for (;;) {
        const bool has_next = S.next(ui + 1, nxt);
        const char* nB = cB;
        if (has_next) { S.a_off(nxt, R, C, noffA); nB = uniform_ptr(S.b_base(nxt)); }
        else {
#pragma unroll
            for (int h = 0; h < 2; ++h)
#pragma unroll
                for (int i = 0; i < 2; ++i) noffA[h][i] = offA[h][i];
        }
#pragma unroll 1
        for (int t = 0; t < nt; t += 2) {
            const bool last = (t == nt - 2);
            const char* a1 = Ab + (size_t)(t + 1) * kstep;
            const char* a2 = last ? Ab : Ab + (size_t)(t + 2) * kstep; const char* b2 = last ? nB : cB + (size_t)(t + 2) * kstep;
            const char* a3 = a2 + kstep; const char* b3 = b2 + kstep;
            unsigned o2[2][2];
#pragma unroll
            for (int h = 0; h < 2; ++h)
#pragma unroll
                for (int i = 0; i < 2; ++i) o2[h][i] = last ? noffA[h][i] : offA[h][i];
            const bool fresh = (t == 0) && (ui > 0);
            PG8_LDB(B0, 0, 0); PG8_LDB(B1, 0, 1); PG8_SCHED; PG8_LDA(At, 0, 0); if (!fresh) PG8_STAGE(PG8_SA(1, 1), a1, offA[1]);
            PG8_WAIT_VF(); PG8_WAIT_L(0); PG8_BAR; PG8_MMA(0, 0, At, B0); PG8_MMA(0, 1, At, B1); PG8_BAR; PG8_SCHED;
            PG8_LDA(At, 0, 1); PG8_STAGE(PG8_SB(0, 0), b2, voffB); PG8_STAGE(PG8_SB(0, 1), b2 + hstepB, voffB); PG8_STAGE(PG8_SA(0, 0), a2, o2[0]);
            PG8_WAIT_VF(); PG8_WAIT_L(0); PG8_BAR; PG8_MMA(1, 0, At, B0); PG8_MMA(1, 1, At, B1); PG8_BAR; PG8_SCHED;
            PG8_LDB(B0, 1, 0); PG8_LDB(B1, 1, 1); PG8_SCHED; PG8_LDA(At, 1, 0); PG8_STAGE(PG8_SA(0, 1), a2, o2[1]);
            PG8_WAIT_VF(); PG8_WAIT_L(0); PG8_BAR; PG8_MMA(0, 0, At, B0); PG8_MMA(0, 1, At, B1); PG8_BAR; PG8_SCHED;
            PG8_LDA(At, 1, 1); PG8_STAGE(PG8_SB(1, 0), b3, voffB); PG8_STAGE(PG8_SB(1, 1), b3 + hstepB, voffB); PG8_STAGE(PG8_SA(1, 0), a3, o2[0]);
            PG8_WAIT_V(8); PG8_WAIT_L(0); PG8_BAR; PG8_MMA(1, 0, At, B0); PG8_MMA(1, 1, At, B1); PG8_BAR; PG8_SCHED;
        }
        if (has_next) PG8_STAGE(PG8_SA(1, 1), Ab + kstep, noffA[1]);
        if (wr == 0) PG8_BAR;
        if constexpr (Prob::esz == 1) asm volatile("s_nop 15\n\ts_nop 15" ::: "memory");
        E(acc, cur, wr, wc, fr, fq);
        if (!has_next) break;
#pragma unroll
        for (int a = 0; a < 2; ++a)
#pragma unroll
            for (int b = 0; b < 2; ++b)
#pragma unroll
                for (int m = 0; m < 4; ++m)
#pragma unroll
                    for (int n = 0; n < 2; ++n) acc[a][b][m][n] = (f32x4){0.f, 0.f, 0.f, 0.f};
        cur = nxt; cB = nB; ++ui;
#pragma unroll
        for (int h = 0; h < 2; ++h)
#pragma unroll
            for (int i = 0; i < 2; ++i) offA[h][i] = noffA[h][i];
        if (wr == 1) PG8_BAR;
    }
    PG8_WAIT_V(0);
    PG8_BAR;
#undef PG8_SA
#undef PG8_SB
#undef PG8_STAGE
#undef PG8_LDA
#undef PG8_LDB
#undef PG8_MMA
#undef PG8_WAIT_V
#undef PG8_WAIT_VF
#undef PG8_WAIT_L
#undef PG8_BAR
#undef PG8_SCHED
}
}

typedef float f32x16 __attribute__((ext_vector_type(16)));
typedef short s16x4 __attribute__((ext_vector_type(4)));
typedef __bf16 bf16x2_t __attribute__((ext_vector_type(2)));
__device__ __forceinline__ unsigned cvtpk(float lo, float hi) { f32x2_t v = {lo, hi}; bf16x2_t b = __builtin_convertvector(v, bf16x2_t); return __builtin_bit_cast(unsigned, b); }
__device__ __forceinline__ int crow(int i, int h) { return (i & 3) + 8 * (i >> 2) + 4 * h; }
__device__ __forceinline__ bf16x8 pack_step(const f32x16& x, int s) {
    u32x4 w; w.x = cvtpk(x[8 * s + 0], x[8 * s + 1]); w.y = cvtpk(x[8 * s + 2], x[8 * s + 3]); w.z = cvtpk(x[8 * s + 4], x[8 * s + 5]); w.w = cvtpk(x[8 * s + 6], x[8 * s + 7]);
    return __builtin_bit_cast(bf16x8, w);
}
#define MFMA32(a, b, c) __builtin_amdgcn_mfma_f32_32x32x16_bf16((a), (b), (c), 0, 0, 0)

constexpr int SWA_KROW = 144;
constexpr int SWA_VROW = 520;
constexpr int SWA_VOFF = 256 * SWA_KROW;

__device__ __forceinline__ void phase_swa(const P& p, int bid, int nblk, LAS unsigned char* lds) {
    const int tid = otid(), wave = __builtin_amdgcn_readfirstlane(tid >> 6), lane = tid & 63, r = lane & 31, h = lane >> 5;
    const bf16_t* QKV = (const bf16_t*)(p.ws + WS_U);
    unsigned char* Z = p.ws + WS_Z;
    LAS unsigned char* Ks = lds;
    LAS unsigned char* Vs = lds + SWA_VOFF;
    constexpr float LOG2E = 1.4426950408889634f;
    const int upb = (NB * 4 * 32) / nblk;
    u32x4 kst[4], vst[4]; bf16x8 qfn[4];
#define SWA_STAGE_LOAD(ID) do { const int id_ = (ID), n_ = id_ & 31, hk_ = (id_ >> 5) & 3, b_ = id_ >> 7; const int kb0_ = (n_ == 0) ? 0 : (n_ - 1) * 128; \
        _Pragma("unroll") for (int q = 0; q < 4; ++q) { const int pc = tid + q * NT, kv = pc >> 3, c8 = pc & 7; \
            const size_t row = (size_t)b_ * SEQ + (kv < 128 ? kb0_ + kv : n_ * 128 + kv - 128); \
            kst[q] = *(const u32x4*)(QKV + row * 1536 + 1024 + hk_ * 64 + c8 * 8); vst[q] = *(const u32x4*)(QKV + row * 1536 + 1280 + hk_ * 64 + c8 * 8); } } while (0)
#define SWA_Q_LOAD(ID, QT) do { const int id_ = (ID), n_ = id_ & 31, hk_ = (id_ >> 5) & 3, b_ = id_ >> 7; const int a_ = (wave & 1) * 2 + (QT); \
        const size_t qrow_ = (size_t)b_ * SEQ + n_ * 128 + a_ * 32 + r; const int hq_ = hk_ * 4 + (wave >> 1); \
        _Pragma("unroll") for (int s = 0; s < 4; ++s) qfn[s] = *(const bf16x8*)(QKV + qrow_ * 1536 + hq_ * 64 + s * 16 + h * 8); } while (0)
    SWA_STAGE_LOAD(bid * upb); SWA_Q_LOAD(bid * upb, 0);
    for (int ui = 0; ui < upb; ++ui) {
        const int id = bid * upb + ui, n = id & 31, hk = (id >> 5) & 3, b = id >> 7;
#pragma unroll
        for (int q = 0; q < 4; ++q) {
            const int pc = tid + q * NT, kv = pc >> 3, c8 = pc & 7;
            const u32x4 kq = kst[q], vq = vst[q];
            *(LAS u32x4*)(Ks + kv * SWA_KROW + c8 * 16) = kq;
            LAS unsigned char* vp = Vs + (c8 * 8) * SWA_VROW + kv * 2;
            *(LAS unsigned short*)(vp + 0 * SWA_VROW) = (unsigned short)(vq.x & 0xffffu); *(LAS unsigned short*)(vp + 1 * SWA_VROW) = (unsigned short)(vq.x >> 16);
            *(LAS unsigned short*)(vp + 2 * SWA_VROW) = (unsigned short)(vq.y & 0xffffu); *(LAS unsigned short*)(vp + 3 * SWA_VROW) = (unsigned short)(vq.y >> 16);
            *(LAS unsigned short*)(vp + 4 * SWA_VROW) = (unsigned short)(vq.z & 0xffffu); *(LAS unsigned short*)(vp + 5 * SWA_VROW) = (unsigned short)(vq.z >> 16);
            *(LAS unsigned short*)(vp + 6 * SWA_VROW) = (unsigned short)(vq.w & 0xffffu); *(LAS unsigned short*)(vp + 7 * SWA_VROW) = (unsigned short)(vq.w >> 16);
        }
        __syncthreads();
        const int hq = hk * 4 + (wave >> 1);
        const float sink = p.swa_sinks[hq];
#pragma unroll 1
        for (int qt = 0; qt < 2; ++qt) {
            const int a = (wave & 1) * 2 + qt;
            const size_t qrow = (size_t)b * SEQ + n * 128 + a * 32 + r;
            bf16x8 qf[4];
#pragma unroll
            for (int s = 0; s < 4; ++s) qf[s] = qfn[s];
            if (qt == 0) SWA_Q_LOAD(id, 1);
            else if (ui + 1 < upb) { SWA_STAGE_LOAD(id + 1); SWA_Q_LOAD(id + 1, 0); }
            f32x16 st[5];
#pragma unroll
            for (int dl = 0; dl < 5; ++dl) {
#pragma unroll
                for (int i = 0; i < 16; ++i) st[dl][i] = 0.f;
                const LAS unsigned char* kp = Ks + ((a + dl) * 32 + r) * SWA_KROW + h * 16;
#pragma unroll
                for (int s = 0; s < 4; ++s) { const bf16x8 kf = *(const LAS bf16x8*)(kp + s * 32); st[dl] = MFMA32(kf, qf[s], st[dl]); }
            }
#pragma unroll
            for (int i = 0; i < 16; ++i) { const int c = crow(i, h); if (!(c > r)) st[0][i] = -INFINITY; if (!(c <= r)) st[4][i] = -INFINITY; }
            if (n == 0) {
#pragma unroll
                for (int dl = 0; dl < 5; ++dl) if (a + dl < 4) {
#pragma unroll
                    for (int i = 0; i < 16; ++i) st[dl][i] = -INFINITY; }
            }
            float m = sink;
#pragma unroll
            for (int dl = 0; dl < 5; ++dl)
#pragma unroll
                for (int i = 0; i < 16; ++i) m = fmaxf(m, st[dl][i]);
            m = fmaxf(m, __shfl_xor(m, 32));
            const float mb = m * LOG2E;
            float l = 0.f;
#pragma unroll
            for (int dl = 0; dl < 5; ++dl)
#pragma unroll
                for (int i = 0; i < 16; ++i) { const float e = __builtin_amdgcn_exp2f(st[dl][i] * LOG2E - mb); st[dl][i] = e; l += e; }
            l += __shfl_xor(l, 32);
            l += __builtin_amdgcn_exp2f(sink * LOG2E - mb);
            f32x16 o[2];
#pragma unroll
            for (int dt = 0; dt < 2; ++dt)
#pragma unroll
                for (int i = 0; i < 16; ++i) o[dt][i] = 0.f;
#pragma unroll
            for (int dl = 0; dl < 5; ++dl)
#pragma unroll
                for (int s = 0; s < 2; ++s) {
                    const bf16x8 pf = pack_step(st[dl], s);
#pragma unroll
                    for (int dt = 0; dt < 2; ++dt) {
                        const LAS unsigned char* vp = Vs + (32 * dt + r) * SWA_VROW + ((a + dl) * 32 + 16 * s + 4 * h) * 2;
                        const s16x4 lo = *(const LAS s16x4*)vp, hi = *(const LAS s16x4*)(vp + 16);
                        const bf16x8 vf = __builtin_shufflevector(lo, hi, 0, 1, 2, 3, 4, 5, 6, 7);
                        o[dt] = MFMA32(vf, pf, o[dt]);
                    }
                }
            const float inv = 8.f / l;
            unsigned char* zp = Z + qrow * D + hq * 64 + 4 * h;
#pragma unroll
            for (int dt = 0; dt < 2; ++dt)
#pragma unroll
                for (int g = 0; g < 4; ++g) *(unsigned*)(zp + 32 * dt + 8 * g) = pk8x4(o[dt][4 * g] * inv, o[dt][4 * g + 1] * inv, o[dt][4 * g + 2] * inv, o[dt][4 * g + 3] * inv);
        }
        __syncthreads();
    }
#undef SWA_STAGE_LOAD
#undef SWA_Q_LOAD
}

constexpr int HG_QT = 0, HG_KT = 17408, HG_KTT = 34816, HG_VT = 53248, HG_TOT = 57856, HG_VEC = 61952, HG_PO = 63488, HG_POA = 96256;
constexpr int HG_P = 272, HG_PT = 144;
#define HG_LBAR() do { asm volatile("s_waitcnt lgkmcnt(0)" ::: "memory"); __builtin_amdgcn_s_barrier(); asm volatile("" ::: "memory"); } while (0)

__device__ __forceinline__ void phase_hgrn(const P& p, int bid, int nblk, LAS unsigned char* lds) {
    const int tid = otid(), wave = __builtin_amdgcn_readfirstlane(tid >> 6), lane = tid & 63, r = lane & 31, h = lane >> 5;
    const bf16_t* U1 = (const bf16_t*)(p.ws + WS_U);
    bf16_t* O = (bf16_t*)(p.ws + WS_O);
    for (int unit = bid; unit < NB * 8 * 4; unit += nblk) {
        const int vs = unit & 3, hh = (unit >> 2) & 7, b = unit >> 5;
        f32x16 S;
#pragma unroll
        for (int i = 0; i < 16; ++i) S[i] = 0.f;
        const bf16_t* qbase = U1 + ((size_t)b * SEQ + wave * 8) * 4096 + hh * 128 + 2 * lane;
        const bf16_t* vbase = U1 + ((size_t)b * SEQ + (tid >> 3)) * 4096 + 2048 + hh * 128 + vs * 32 + (tid & 7) * 4;
        unsigned qraw[8], kraw[8], qnx[8], knx[8]; u32x2 vraw, vnx;
#pragma unroll
        for (int i = 0; i < 8; ++i) { qraw[i] = *(const unsigned*)(qbase + (size_t)i * 4096); kraw[i] = *(const unsigned*)(qbase + (size_t)i * 4096 + 1024); }
        vraw = *(const u32x2*)vbase;
        asm volatile("" :: "v"(qraw[0]), "v"(qraw[1]), "v"(qraw[2]), "v"(qraw[3]), "v"(qraw[4]), "v"(qraw[5]), "v"(qraw[6]), "v"(qraw[7]), "v"(kraw[0]), "v"(kraw[1]), "v"(kraw[2]), "v"(kraw[3]), "v"(kraw[4]), "v"(kraw[5]), "v"(kraw[6]), "v"(kraw[7]), "v"(vraw));
#pragma unroll 1
        for (int c = 0; c < SEQ / 64; ++c) {
            {
                const int cn = (c + 1 < SEQ / 64) ? c + 1 : SEQ / 64 - 1;
                const size_t adv = (size_t)cn * 64 * 4096;
#pragma unroll
                for (int i = 0; i < 8; ++i) { qnx[i] = *(const unsigned*)(qbase + adv + (size_t)i * 4096); knx[i] = *(const unsigned*)(qbase + adv + (size_t)i * 4096 + 1024); }
                vnx = *(const u32x2*)(vbase + adv);
                asm volatile("" ::: "memory");
            }
            float q0[8], q1[8], k0[8], k1[8], c0[8], c1[8];
            float a0 = 1.f, a1 = 1.f;
#pragma unroll
            for (int i = 0; i < 8; ++i) { q0[i] = bflo(qraw[i]); q1[i] = bfhi(qraw[i]); k0[i] = bflo(kraw[i]); k1[i] = bfhi(kraw[i]);
                a0 *= 1.f - k0[i]; a1 *= 1.f - k1[i]; c0[i] = a0; c1[i] = a1; }
            { f32x2_t tv = {a0, a1}; *(LAS f32x2_t*)(lds + HG_TOT + (wave * 128 + 2 * lane) * 4) = tv; }
            const u32x2 vcur = vraw;
            HG_LBAR();
            float lo0 = 1.f, lo1 = 1.f, hi0 = 1.f, hi1 = 1.f, em0 = 1.f, em1 = 1.f, el0 = 1.f, el1 = 1.f;
#pragma unroll
            for (int w2 = 0; w2 < 8; ++w2) { const f32x2_t tv = *(const LAS f32x2_t*)(lds + HG_TOT + (w2 * 128 + 2 * lane) * 4);
                if (w2 < 4) { em0 *= tv.x; em1 *= tv.y; if (w2 >= wave) { lo0 *= tv.x; lo1 *= tv.y; } }
                else { el0 *= tv.x; el1 *= tv.y; if (w2 < wave) { hi0 *= tv.x; hi1 *= tv.y; } } }
            const float sc0 = (wave >= 4) ? hi0 : __builtin_amdgcn_rcpf(lo0), sc1 = (wave >= 4) ? hi1 : __builtin_amdgcn_rcpf(lo1);
            u32x4 kt0, kt1;
            unsigned ktw0[4], ktw1[4];
#pragma unroll
            for (int i = 0; i < 8; i += 2) {
                const float e00 = c0[i] * sc0, e01 = c1[i] * sc1, e10 = c0[i + 1] * sc0, e11 = c1[i + 1] * sc1;
                const float r00 = __builtin_amdgcn_rcpf(e00), r01 = __builtin_amdgcn_rcpf(e01), r10 = __builtin_amdgcn_rcpf(e10), r11 = __builtin_amdgcn_rcpf(e11);
                const float kk00 = k0[i] * r00, kk01 = k1[i] * r01, kk10 = k0[i + 1] * r10, kk11 = k1[i + 1] * r11;
                const int t = wave * 8 + i;
                *(LAS unsigned*)(lds + HG_QT + t * HG_P + lane * 4) = cvtpk(q0[i] * e00, q1[i] * e01);
                *(LAS unsigned*)(lds + HG_QT + (t + 1) * HG_P + lane * 4) = cvtpk(q0[i + 1] * e10, q1[i + 1] * e11);
                *(LAS unsigned*)(lds + HG_KT + t * HG_P + lane * 4) = cvtpk(kk00, kk01);
                *(LAS unsigned*)(lds + HG_KT + (t + 1) * HG_P + lane * 4) = cvtpk(kk10, kk11);
                ktw0[i >> 1] = cvtpk(kk00, kk10); ktw1[i >> 1] = cvtpk(kk01, kk11);
            }
            kt0.x = ktw0[0]; kt0.y = ktw0[1]; kt0.z = ktw0[2]; kt0.w = ktw0[3]; kt1.x = ktw1[0]; kt1.y = ktw1[1]; kt1.z = ktw1[2]; kt1.w = ktw1[3];
            *(LAS u32x4*)(lds + HG_KTT + (2 * lane) * HG_PT + wave * 16) = kt0;
            *(LAS u32x4*)(lds + HG_KTT + (2 * lane + 1) * HG_PT + wave * 16) = kt1;
            if (wave == 0) {
                f32x2_t em = {em0, em1}, el = {el0, el1}, gg = {em0 * el0, em1 * el1};
                *(LAS f32x2_t*)(lds + HG_VEC + (2 * lane) * 4) = em; *(LAS f32x2_t*)(lds + HG_VEC + 512 + (2 * lane) * 4) = el; *(LAS f32x2_t*)(lds + HG_VEC + 1024 + (2 * lane) * 4) = gg;
            }
            { const int s = tid >> 3, j4 = (tid & 7) * 4; LAS unsigned char* vp = lds + HG_VT + j4 * HG_PT + s * 2;
                *(LAS unsigned short*)(vp) = (unsigned short)(vcur.x & 0xffffu); *(LAS unsigned short*)(vp + HG_PT) = (unsigned short)(vcur.x >> 16);
                *(LAS unsigned short*)(vp + 2 * HG_PT) = (unsigned short)(vcur.y & 0xffffu); *(LAS unsigned short*)(vp + 3 * HG_PT) = (unsigned short)(vcur.y >> 16); }
            HG_LBAR();
            if (wave < 4) {
                const int w = wave;
                f32x4 emv[4], elv[4], gv[4];
#pragma unroll
                for (int g4 = 0; g4 < 4; ++g4) { const int d = 32 * w + 8 * g4 + 4 * h;
                    emv[g4] = *(const LAS f32x4*)(lds + HG_VEC + d * 4); elv[g4] = *(const LAS f32x4*)(lds + HG_VEC + 512 + d * 4); gv[g4] = *(const LAS f32x4*)(lds + HG_VEC + 1024 + d * 4); }
                f32x16 Sem;
#pragma unroll
                for (int i = 0; i < 16; ++i) Sem[i] = S[i] * emv[i >> 2][i & 3];
                const bf16x8 bS0 = pack_step(Sem, 0), bS1 = pack_step(Sem, 1);
#pragma unroll
                for (int tt = 0; tt < 2; ++tt) {
                    f32x16 op;
#pragma unroll
                    for (int i = 0; i < 16; ++i) op[i] = 0.f;
#pragma unroll
                    for (int sp = 0; sp < 2; ++sp) {
                        const LAS unsigned char* ap = lds + HG_QT + (32 * tt + r) * HG_P + (32 * w + 16 * sp + 4 * h) * 2;
                        const s16x4 lo = *(const LAS s16x4*)ap, hi = *(const LAS s16x4*)(ap + 16);
                        const bf16x8 aq = __builtin_shufflevector(lo, hi, 0, 1, 2, 3, 4, 5, 6, 7);
                        op = MFMA32(aq, sp == 0 ? bS0 : bS1, op);
                    }
#pragma unroll
                    for (int g4 = 0; g4 < 4; ++g4) { f32x4 v = {op[4 * g4], op[4 * g4 + 1], op[4 * g4 + 2], op[4 * g4 + 3]};
                        *(LAS f32x4*)(lds + HG_PO + ((w * 2 + tt) * 4 + g4) * 1024 + lane * 16) = v; }
                }
                f32x16 dS;
#pragma unroll
                for (int i = 0; i < 16; ++i) dS[i] = 0.f;
#pragma unroll
                for (int ks = 0; ks < 4; ++ks) {
                    const bf16x8 ak = *(const LAS bf16x8*)(lds + HG_KTT + (32 * w + r) * HG_PT + (16 * ks + 8 * h) * 2);
                    const bf16x8 bv = *(const LAS bf16x8*)(lds + HG_VT + r * HG_PT + (16 * ks + 8 * h) * 2);
                    dS = MFMA32(ak, bv, dS);
                }
#pragma unroll
                for (int i = 0; i < 16; ++i) S[i] = S[i] * gv[i >> 2][i & 3] + dS[i] * elv[i >> 2][i & 3];
            } else if (wave < 7) {
                const int ss = (wave == 6) ? 1 : 0, tt = (wave == 4) ? 0 : 1;
                f32x16 at;
#pragma unroll
                for (int i = 0; i < 16; ++i) at[i] = 0.f;
#pragma unroll
                for (int kd = 0; kd < 8; ++kd) {
                    const bf16x8 ak = *(const LAS bf16x8*)(lds + HG_KT + (32 * ss + r) * HG_P + (16 * kd + 8 * h) * 2);
                    const bf16x8 bq = *(const LAS bf16x8*)(lds + HG_QT + (32 * tt + r) * HG_P + (16 * kd + 8 * h) * 2);
                    at = MFMA32(ak, bq, at);
                }
                if (ss == tt) {
#pragma unroll
                    for (int i = 0; i < 16; ++i) if (crow(i, h) > r) at[i] = 0.f;
                }
                f32x16 oi;
#pragma unroll
                for (int i = 0; i < 16; ++i) oi[i] = 0.f;
#pragma unroll
                for (int sp = 0; sp < 2; ++sp) {
                    const bf16x8 pa = pack_step(at, sp);
                    const LAS unsigned char* vp = lds + HG_VT + r * HG_PT + (32 * ss + 16 * sp + 4 * h) * 2;
                    const s16x4 lo = *(const LAS s16x4*)vp, hi = *(const LAS s16x4*)(vp + 16);
                    const bf16x8 vb = __builtin_shufflevector(lo, hi, 0, 1, 2, 3, 4, 5, 6, 7);
                    oi = MFMA32(pa, vb, oi);
                }
#pragma unroll
                for (int g4 = 0; g4 < 4; ++g4) { f32x4 v = {oi[4 * g4], oi[4 * g4 + 1], oi[4 * g4 + 2], oi[4 * g4 + 3]};
                    *(LAS f32x4*)(lds + HG_POA + ((wave - 4) * 4 + g4) * 1024 + lane * 16) = v; }
            }
            HG_LBAR();
            {
                const int tt = wave >> 2, g4 = wave & 3;
                f32x4 sum = *(const LAS f32x4*)(lds + HG_PO + ((0 * 2 + tt) * 4 + g4) * 1024 + lane * 16);
#pragma unroll
                for (int w2 = 1; w2 < 4; ++w2) sum += *(const LAS f32x4*)(lds + HG_PO + ((w2 * 2 + tt) * 4 + g4) * 1024 + lane * 16);
                if (tt == 0) sum += *(const LAS f32x4*)(lds + HG_POA + (0 * 4 + g4) * 1024 + lane * 16);
                else { sum += *(const LAS f32x4*)(lds + HG_POA + (1 * 4 + g4) * 1024 + lane * 16); sum += *(const LAS f32x4*)(lds + HG_POA + (2 * 4 + g4) * 1024 + lane * 16); }
                bf16_t* op_ = O + ((size_t)b * SEQ + c * 64 + 32 * tt + 8 * g4 + 4 * h) * D + hh * 128 + vs * 32 + r;
#pragma unroll
                for (int e = 0; e < 4; ++e) op_[(size_t)e * D] = (bf16_t)f2bf(sum[e]);
            }
            asm volatile("" ::: "memory");
#pragma unroll
            for (int i = 0; i < 8; ++i) { qraw[i] = qnx[i]; kraw[i] = knx[i]; }
            vraw = vnx;
            asm volatile("" :: "v"(qraw[0]), "v"(qraw[1]), "v"(qraw[2]), "v"(qraw[3]), "v"(qraw[4]), "v"(qraw[5]), "v"(qraw[6]), "v"(qraw[7]), "v"(kraw[0]), "v"(kraw[1]), "v"(kraw[2]), "v"(kraw[3]), "v"(kraw[4]), "v"(kraw[5]), "v"(kraw[6]), "v"(kraw[7]), "v"(vraw));
        }
        __syncthreads();
    }
}

#define XB_TMO      128
#define XB_XCNT(j)  (256  + 64 * (j))
#define XB_XSUB(j)  (1280 + 64 * (j))
#define XB_XGEN(j)  (2304 + 64 * (j))
#define XB_TOP      3328
#define XB_TOPGEN   3392
#define XCD_BAR_WORDS 3456
#define XB_SPIN_CAP (1u << 18)

__device__ __forceinline__ unsigned xb_ld(unsigned* p)              { return __hip_atomic_load(p, __ATOMIC_RELAXED, __HIP_MEMORY_SCOPE_AGENT); }
__device__ __forceinline__ unsigned xb_add(unsigned* p, unsigned v) { return __hip_atomic_fetch_add(p, v, __ATOMIC_RELAXED, __HIP_MEMORY_SCOPE_AGENT); }
__device__ __forceinline__ unsigned xb_xcc_id() { return (unsigned)__builtin_amdgcn_s_getreg((3 << 11) | 20) & 0xFu; }
#define XB_SPIN(cond, bar) do { unsigned _sp = 0; while (cond) { __builtin_amdgcn_s_sleep(1); \
    if ((++_sp & 255u) == 0u) { if (xb_ld(&(bar)[XB_TMO])) break; if (_sp > XB_SPIN_CAP) { atomicAdd(&(bar)[XB_TMO], 1u); break; } } } } while (0)

struct XcdBarrier {
    unsigned* bar; unsigned x;
    volatile LAS unsigned* st;
};
__device__ __forceinline__ XcdBarrier xcd_barrier_post(unsigned* bar, volatile LAS unsigned* st) {
    XcdBarrier b; b.bar = bar; b.x = xb_xcc_id(); b.st = st;
    if (threadIdx.x == 0) (void)xb_add(&bar[XB_XCNT(b.x)], 1u);
    return b;
}
__device__ __forceinline__ void xcd_barrier_complete(unsigned* bar, unsigned x, unsigned& nloc, unsigned& nx) {
    const unsigned G = gridDim.x * gridDim.y * gridDim.z;
    unsigned sum, cnt, mine, sp = 0u;
    for (;;) {
        sum = 0u; cnt = 0u; mine = 0u;
#pragma unroll
        for (unsigned j = 0; j < 16; ++j) { const unsigned c = xb_ld(&bar[XB_XCNT(j)]); sum += c; cnt += (c > 0u) ? 1u : 0u; mine = (j == x) ? c : mine; }
        if (sum == G) break;
        __builtin_amdgcn_s_sleep(1);
        if ((++sp & 255u) == 0u) { if (xb_ld(&bar[XB_TMO])) break; if (sp > XB_SPIN_CAP) { atomicAdd(&bar[XB_TMO], 1u); break; } }
    }
    nloc = mine > 0u ? mine : 1u; nx = cnt > 0u ? cnt : 1u;
}
__device__ __forceinline__ void xcd_barrier(const XcdBarrier& b) {
    asm volatile("s_waitcnt vmcnt(0)" ::: "memory");
    __syncthreads();
    if (threadIdx.x == 0) {
        unsigned* bar = b.bar;
        __builtin_amdgcn_s_waitcnt(0);
        unsigned nloc = b.st[0], nx = b.st[1];
        if (nloc == 0u) { xcd_barrier_complete(bar, b.x, nloc, nx); b.st[0] = nloc; b.st[1] = nx; }
        const unsigned old = xb_add(&bar[XB_XSUB(b.x)], 1u);
        const unsigned gen = old / nloc;
        if (old + 1u == (gen + 1u) * nloc) {
            __builtin_amdgcn_fence(__ATOMIC_RELEASE, "agent");
            asm volatile("s_waitcnt vmcnt(0)" ::: "memory");
            const unsigned og = xb_add(&bar[XB_TOP], 1u);
            const unsigned tg = og / nx;
            if (og + 1u == (tg + 1u) * nx) xb_add(&bar[XB_TOPGEN], 1u);
            else XB_SPIN(xb_ld(&bar[XB_TOPGEN]) == tg, bar);
            __builtin_amdgcn_fence(__ATOMIC_ACQUIRE, "agent");
            xb_add(&bar[XB_XGEN(b.x)], 1u);
            asm volatile("s_waitcnt vmcnt(0)" ::: "memory");
        } else {
            XB_SPIN(xb_ld(&bar[XB_XGEN(b.x)]) == gen, bar);
            __builtin_amdgcn_fence(__ATOMIC_ACQUIRE, "agent");
            asm volatile("s_waitcnt vmcnt(0)" ::: "memory");
        }
    }
    __syncthreads();
}

__device__ __forceinline__ void cvt_item(const float* W, int ldw, int k0, int n0, bf16_t* WT, int ldt, int drow0, LAS unsigned char* T, int lane) {
    const int kp = lane >> 5, nq = lane & 31;
    const float* src = W + (size_t)(k0 + 2 * kp) * ldw + n0 + 4 * nq;
    const unsigned sw = (unsigned)(nq & 28);
#pragma unroll
    for (int half = 0; half < 2; ++half) {
        f32x4 v[8][2];
#pragma unroll
        for (int s = 0; s < 8; ++s) { const float* q = src + (size_t)(4 * (half * 8 + s)) * ldw; v[s][0] = *(const f32x4*)q; v[s][1] = *(const f32x4*)(q + ldw); }
#pragma unroll
        for (int s = 0; s < 8; ++s) {
            const unsigned pd = (unsigned)(2 * (half * 8 + s) + kp);
            const unsigned col = ((pd ^ sw) << 2);
#pragma unroll
            for (int i = 0; i < 4; ++i) *(LAS unsigned*)(T + (4 * nq + i) * 128 + col) = pk2(v[s][0][i], v[s][1][i]);
        }
    }
    asm volatile("s_waitcnt lgkmcnt(0)" ::: "memory");
    const int c = lane & 7;
#pragma unroll 4
    for (int q = 0; q < 16; ++q) {
        const int n = 8 * q + (lane >> 3);
        const u32x4 o = *(const LAS u32x4*)(T + n * 128 + (((unsigned)(4 * c) ^ (unsigned)((n >> 2) & 28)) << 2));
        *(u32x4*)(WT + (size_t)(drow0 + n) * ldt + k0 + 8 * c) = o;
    }
    asm volatile("s_waitcnt lgkmcnt(0)" ::: "memory");
}
__device__ __forceinline__ int dual_row(int n, int half) { return (n >> 7) * 256 + half * 128 + (n & 127); }

__device__ __forceinline__ unsigned pk_fp8x4_(float a, float b, float c, float d) { return pk8x4(a, b, c, d); }
struct CvtSrc { const float* W; unsigned char* WT; int ldw, k0, n0, drow0; };
__device__ __forceinline__ void cvt8_issue(const CvtSrc& s, int qt, int lane, f32x4 (&v)[4][4]) {
    const int kp = lane >> 5, nq = lane & 31;
    const float* ub = s.W + (size_t)(s.k0 + 32 * qt) * s.ldw + s.n0;
    const unsigned lo = (unsigned)(4 * kp * s.ldw + 4 * nq);
#pragma unroll
    for (int st = 0; st < 4; ++st)
#pragma unroll
        for (int rr = 0; rr < 4; ++rr) v[st][rr] = __builtin_nontemporal_load((const f32x4*)(ub + (size_t)(8 * st + rr) * s.ldw + lo));
}
__device__ __forceinline__ void cvt8_pack(int qt, int lane, const f32x4 (&v)[4][4], LAS unsigned char* T, float scale) {
    const int kp = lane >> 5, nq = lane & 31;
    const unsigned sw = (unsigned)(nq & 28);
#pragma unroll
    for (int st = 0; st < 4; ++st) {
        const unsigned pd = (unsigned)(2 * (qt * 4 + st) + kp);
        const unsigned col = ((pd ^ sw) << 2);
#pragma unroll
        for (int i = 0; i < 4; ++i) *(LAS unsigned*)(T + (4 * nq + i) * 128 + col) = pk_fp8x4_(v[st][0][i] * scale, v[st][1][i] * scale, v[st][2][i] * scale, v[st][3][i] * scale);
    }
}
__device__ __forceinline__ void cvt8_flush(const CvtSrc& s, int lane, LAS unsigned char* T) {
    asm volatile("s_waitcnt lgkmcnt(0)" ::: "memory");
    const int c = lane & 7;
#pragma unroll 4
    for (int q = 0; q < 16; ++q) {
        const int n = 8 * q + (lane >> 3);
        const u32x4 o = *(const LAS u32x4*)(T + n * 128 + (((unsigned)(4 * c) ^ (unsigned)((n >> 2) & 28)) << 2));
        *(u32x4*)(s.WT + (size_t)(s.drow0 + n) * 1024 + s.k0 + 16 * c) = o;
    }
    asm volatile("s_waitcnt lgkmcnt(0)" ::: "memory");
}

constexpr int CVPRO = 1;
constexpr int CV_LAYER_ITEMS = 3 * 16 * 64;
constexpr float W8_SCALE = 32.f;
__device__ __forceinline__ CvtSrc moe_item(const P& p, int layer, int it) {
    const int tsr = it >> 10, r = it & 1023, le = layer * NE + (r >> 6), item = r & 63, kb = item >> 3, nb = item & 7;
    CvtSrc s; s.ldw = 1024; s.k0 = kb * 128; s.n0 = nb * 128;
    if (tsr == 0)      { s.W = p.moe_w_gate + (size_t)le * D * FF; s.WT = p.ws + WT_GU + (size_t)le * 2048 * 1024; s.drow0 = dual_row(nb * 128, 0); }
    else if (tsr == 1) { s.W = p.moe_w_up + (size_t)le * D * FF;   s.WT = p.ws + WT_GU + (size_t)le * 2048 * 1024; s.drow0 = dual_row(nb * 128, 1); }
    else               { s.W = p.moe_w_down + (size_t)le * FF * D; s.WT = p.ws + WT_DN + (size_t)le * 1024 * 1024; s.drow0 = nb * 128; }
    return s;
}
constexpr int CV_DENSE8_ITEMS = 64 + 256 + 96 + 192 + 3 * 64;
__device__ __forceinline__ CvtSrc dense8_item(const P& p, int r) {
    CvtSrc s;
    if (r < 64) { const int kb = r >> 3, nb = r & 7; s.W = p.pool_w_in; s.WT = p.ws + WT_POOL_IN; s.ldw = 1024; s.k0 = kb * 128; s.n0 = nb * 128; s.drow0 = nb * 128; return s; } r -= 64;
    if (r < 256) { const int kb = r >> 5, nb = r & 31; s.W = p.hgrn_w_in; s.WT = p.ws + WT_HGRN_IN; s.ldw = 4096; s.k0 = kb * 128; s.n0 = nb * 128; s.drow0 = nb * 128; return s; } r -= 256;
    if (r < 96) { const int kb = r / 12, nb = r % 12; s.W = p.swa_w_in; s.WT = p.ws + WT_SWA_IN; s.ldw = 1536; s.k0 = kb * 128; s.n0 = nb * 128; s.drow0 = nb * 128; return s; } r -= 96;
    if (r >= 192) { r -= 192; const int w = r >> 6, kb = (r >> 3) & 7, nb = r & 7; s.W = w == 0 ? p.hgrn_w_out : (w == 1 ? p.swa_w_out : p.conv_w_out);
        s.WT = p.ws + (w == 0 ? WT_HGRN_OUT : (w == 1 ? WT_SWA_OUT : WT_CONV_OUT)); s.ldw = 1024; s.k0 = kb * 128; s.n0 = nb * 128; s.drow0 = nb * 128; return s; }
    { const int kb = r / 24, nb = r % 24, n0 = nb * 128; s.W = p.conv_w_in; s.WT = p.ws + WT_CONV_IN; s.ldw = 3072; s.k0 = kb * 128; s.n0 = n0;
      s.drow0 = n0 < 1024 ? n0 : (n0 < 2048 ? 1024 + dual_row(n0 - 1024, 0) : 1024 + dual_row(n0 - 2048, 1)); return s; }
}
__device__ __forceinline__ CvtSrc any8_item(const P& p, int layer, int it) { return it < CV_LAYER_ITEMS ? moe_item(p, layer, it) : dense8_item(p, it - CV_LAYER_ITEMS); }
__device__ __forceinline__ void convert_moe(const P& p, int layer, int i0, int i1, int vw, int nvw, LAS unsigned char* T, int lane) {
    int it = __builtin_amdgcn_readfirstlane(i0 + vw);
    if (it >= i1) return;
    f32x4 va[4][4], vb[4][4];
    CvtSrc cur = any8_item(p, layer, it);
    cvt8_issue(cur, 0, lane, va); cvt8_issue(cur, 1, lane, vb);
    for (;;) {
        cvt8_pack(0, lane, va, T, W8_SCALE); cvt8_issue(cur, 2, lane, va);
        cvt8_pack(1, lane, vb, T, W8_SCALE); cvt8_issue(cur, 3, lane, vb);
        const int nx = it + nvw; const bool more = nx < i1;
        const CvtSrc nxt = any8_item(p, layer, more ? nx : it);
        cvt8_pack(2, lane, va, T, W8_SCALE); if (more) cvt8_issue(nxt, 0, lane, va);
        cvt8_pack(3, lane, vb, T, W8_SCALE); if (more) cvt8_issue(nxt, 1, lane, vb);
        cvt8_flush(cur, lane, T);
        if (!more) break;
        cur = nxt; it = nx;
    }
}

__device__ __forceinline__ void phase_convert(const P& p, int bid, int nblk, LAS unsigned char* lds) {
    const int tid = otid(), wave = tid >> 6, lane = tid & 63;
    LAS unsigned char* T = lds + wave * 16384;
    const int gw = bid * NWV + wave, NGW = nblk * NWV;
    unsigned char* ws = p.ws;
    for (int ly = 0; ly < CVPRO; ++ly) convert_moe(p, ly, 0, CV_LAYER_ITEMS + (ly == 0 ? CV_DENSE8_ITEMS : 0), gw, NGW, T, lane);
    constexpr int I_SQ = 128, I_GRP = 32;
    constexpr int NSMALL = I_SQ + I_GRP;
    for (int it = (gw + NGW - (CV_LAYER_ITEMS + CV_DENSE8_ITEMS) % NGW) % NGW; it < NSMALL; it += NGW) {
        int r = it;
        if (r < I_GRP) {
#pragma unroll 4
            for (int q = 0; q < 32; ++q) { const int e4 = r * 2048 + q * 64 + lane, e = e4 * 4, g = e >> 16, d = e & 255; const f32x4 w = *(const f32x4*)(p.pool_w_grp + e) * *(const f32x4*)(p.pool_scale + g * 256 + d);
                u32x2 o; o.x = pk2(w.x, w.y); o.y = pk2(w.z, w.w); *(u32x2*)((bf16_t*)(ws + WT_POOL_GRP) + e) = o; }
            continue; } r -= I_GRP;
        if (r < I_SQ) { cvt_item(p.pool_w_out, D, (r >> 3) * 64, (r & 7) * 128, (bf16_t*)(ws + WT_POOL_OUT), D, (r & 7) * 128, T, lane); continue; } r -= I_SQ;
    }
}

constexpr int LDS_RING = pg8::STAGE_BYTES;
constexpr int LDS_MISC = LDS_RING;
constexpr int LDS_ROWTAB = LDS_RING + 1024;
constexpr int LDS_BYTES = LDS_ROWTAB + 12 * 1024;
constexpr int NPHASE = 31;
constexpr int CV1 = 40, CV2 = 40, CVSPLIT = 2048;

__global__ void __launch_bounds__(NT, 2) mega(P p, int lo, int hi) {
    extern __shared__ __attribute__((aligned(16))) unsigned char lds_raw[];
    LAS unsigned char* lds = (LAS unsigned char*)lds_raw;
    float* ldsf = (float*)lds_raw;
    const int tid = threadIdx.x, bid = blockIdx.x, nblk = gridDim.x;
    unsigned char* ws = p.ws;
    unsigned* ctl = (unsigned*)(ws + WS_CTL);
    const float* mod = (const float*)(ws + WS_MOD);
    const unsigned char* H8 = ws + WS_H; bf16_t* H = (bf16_t*)(ws + WS_H); bf16_t* Z = (bf16_t*)(ws + WS_Z); bf16_t* U = (bf16_t*)(ws + WS_U);
    bf16_t* U2 = (bf16_t*)(ws + WS_U + ((size_t)64 << 20));
    bf16_t* ACT = (bf16_t*)(ws + WS_ACT); bf16_t* Y = (bf16_t*)(ws + WS_Y);
    LAS int* geo = (LAS int*)(lds + LDS_MISC + 16);
    if (tid < 4) ((LAS unsigned*)(lds + LDS_MISC))[tid] = 0u;
    __syncthreads();
    XcdBarrier bar; bar.bar = ctl; bar.x = 0; bar.st = nullptr;
    if (hi - lo > 1) bar = xcd_barrier_post(ctl, (volatile LAS unsigned*)(lds + LDS_MISC));
    int ph = 0;
#define XOUT ((bf16_t*)(ws + WS_XB))
#define CNTL l
#define PH_BEGIN if (lo <= ph && ph < hi) {
#define PH_END if (ph + 1 < hi) xcd_barrier(bar); else __syncthreads(); } ++ph;

    PH_BEGIN  phase_prep(p, bid, nblk, ldsf); __syncthreads(); phase_convert(p, bid, nblk, lds);  PH_END

    for (int l = 0; l < DEPTH; ++l) {
        PH_BEGIN  if (l == 0) { phase_norm<0>(p, l, bid, nblk, ldsf);
                pg8::DenseProb S{(const bf16_t*)(ws + WT_POOL_OUT), (const bf16_t*)(ws + WT_POOL_GRP), D, 256, 256, 4, 4, nblk, bid}; pg8::EpPlain E{(bf16_t*)(ws + WT_POOL_W2), nullptr, D, 1.f, 0, 1.f}; pg8::gemm_phase(lds, S, E, 256); }
            else phase_norm<1>(p, l, bid, nblk, ldsf, -1, XOUT);  PH_END
        const bf16_t* wout; const bf16_t* aout = Z;
        if (l == 0) {
            PH_BEGIN  { pg8::DenseProb8 S{H8, ws + WT_POOL_IN, D, D, M / 256, 4, nblk, bid, 127, 122}; pg8::EpPlain E{U, nullptr, D, 1.f, 0, 0.03125f}; pg8::gemm_phase(lds, S, E, D); }  PH_END
            PH_BEGIN  phase_pool(p, bid, nblk);  PH_END
            wout = (const bf16_t*)(ws + WT_POOL_W2); aout = U2;
        } else if (l == 1) {
            PH_BEGIN  { pg8::DenseProb8 S{H8, ws + WT_HGRN_IN, D, D, M / 256, 16, nblk, bid, 127, 122}; pg8::EpHgrnIn E{U, (const float*)(ws + WS_LB)}; pg8::gemm_phase(lds, S, E, D); }  PH_END
            PH_BEGIN  phase_hgrn(p, bid, nblk, lds);  PH_END
            PH_BEGIN  phase_hgrn_gate(p, bid, nblk);  PH_END
            wout = (const bf16_t*)(ws + WT_HGRN_OUT);
        } else if (l == 2) {
            PH_BEGIN  { pg8::DenseProb8 S{H8, ws + WT_SWA_IN, D, D, M / 256, 6, nblk, bid, 127, 122}; pg8::EpPlain E{U, nullptr, 1536, 0.125f * 0.03125f, 4, 0.03125f}; pg8::gemm_phase(lds, S, E, D); }  PH_END
            PH_BEGIN  phase_swa(p, bid, nblk, lds);  PH_END
            wout = (const bf16_t*)(ws + WT_SWA_OUT);
        } else {
            PH_BEGIN  { pg8::DenseProb8 S{H8, ws + WT_CONV_IN, D, D, M / 256, 12, nblk, bid, 127, 122}; pg8::EpConvIn E{U, U2}; pg8::gemm_phase(lds, S, E, D); }  PH_END
            PH_BEGIN  phase_conv(p, bid, nblk);  PH_END
            wout = (const bf16_t*)(ws + WT_CONV_OUT);
        }
        PH_BEGIN  {
            if (l == 0) { pg8::DenseProb S{aout, wout, D, D, 0, M / 256, 4, nblk, bid}; pg8::EpResid E{(const bf16_t*)(ws + WS_XB), mod + (size_t)l * NB * 6 * D + 2 * D, XOUT, 1.f, 0}; pg8::gemm_phase(lds, S, E, D); }
            else { pg8::DenseProb8 S{(const unsigned char*)aout, (const unsigned char*)wout, D, D, M / 256, 4, nblk, bid, 127, 122};
                pg8::EpResid E{(const bf16_t*)(ws + WS_XB), mod + (size_t)l * NB * 6 * D + 2 * D, XOUT, 1.f / 256.f, 0}; pg8::gemm_phase(lds, S, E, D); } }  PH_END
        PH_BEGIN  phase_norm3(p, l, bid, nblk, ldsf, CNTL);  PH_END
        PH_BEGIN  {
            if (tid < 64) {
                const int c = tid < NE ? (int)__hip_atomic_load(ctl + CW_CNT + (l * 16 + tid) * 64, __ATOMIC_RELAXED, __HIP_MEMORY_SCOPE_AGENT) : 0;
                const int tl = (c + 255) >> 8; int ps = tl;
#pragma unroll
                for (int o = 1; o < 16; o <<= 1) { const int v = __shfl_up(ps, o); if ((tid & 63) >= o) ps += v; }
                if (tid < NE) { geo[tid] = ps - tl; geo[NE + 1 + tid] = c; }
                if (tid == NE - 1) geo[NE] = ps;
            }
            __syncthreads();
            const int ng1 = (l + 1 < DEPTH && l + 1 >= CVPRO) ? nblk - CV1 : nblk;
            if (bid < ng1) {
                pg8::MoeProb S{(const unsigned char*)H, ws + WT_GU + (size_t)l * NE * 2048 * 1024, (size_t)2048 * 1024, (const int*)(ws + WS_RTOK), geo, (const LAS unsigned*)(lds + LDS_ROWTAB), D, D, 8, ng1, bid, 1, 127, 122};
                S.fill_rowtab<0, 12>((LAS unsigned*)(lds + LDS_ROWTAB), tid); __syncthreads();
                pg8::EpSwiGlu E{(unsigned char*)ACT}; pg8::gemm_phase(lds, S, E, D);
            } else convert_moe(p, l + 1, 0, CVSPLIT, (bid - ng1) * NWV + (otid() >> 6), CV1 * NWV, lds + (otid() >> 6) * 16384, otid() & 63); }  PH_END
        PH_BEGIN  {
            if (tid < 64) {
                const int c = tid < NE ? (int)__hip_atomic_load(ctl + CW_CNT + (l * 16 + tid) * 64, __ATOMIC_RELAXED, __HIP_MEMORY_SCOPE_AGENT) : 0;
                const int tl = (c + 255) >> 8; int ps = tl;
#pragma unroll
                for (int o = 1; o < 16; o <<= 1) { const int v = __shfl_up(ps, o); if ((tid & 63) >= o) ps += v; }
                if (tid < NE) { geo[tid] = ps - tl; geo[NE + 1 + tid] = c; }
                if (tid == NE - 1) geo[NE] = ps;
            }
            __syncthreads();
            const int ng2 = (l + 1 < DEPTH && l + 1 >= CVPRO) ? nblk - CV2 : nblk;
            if (bid < ng2) {
                pg8::MoeProb S{(const unsigned char*)ACT, ws + WT_DN + (size_t)l * NE * 1024 * 1024, (size_t)1024 * 1024, (const int*)(ws + WS_RTOK), geo, (const LAS unsigned*)(lds + LDS_ROWTAB), FF, FF, 4, ng2, bid, 0, 124, 122};
                S.fill_rowtab<1, 6>((LAS unsigned*)(lds + LDS_ROWTAB), tid); __syncthreads();
                pg8::EpY8 E{(unsigned char*)Y, (const LAS unsigned*)(lds + LDS_ROWTAB)}; pg8::gemm_phase(lds, S, E, FF);
            } else convert_moe(p, l + 1, CVSPLIT, CV_LAYER_ITEMS, (bid - ng2) * NWV + (otid() >> 6), CV2 * NWV, lds + (otid() >> 6) * 16384, otid() & 63); }  PH_END
    }
    PH_BEGIN  phase_norm<2>(p, DEPTH, bid, nblk, ldsf, -1, XOUT);  PH_END
#undef PH_BEGIN
#undef PH_END
}

#ifndef MK_ONE_LAUNCH
#define MK_ONE_LAUNCH 1
#endif
extern "C" void kernel_launch(void* const* d_in, const int* in_sizes, int n_in, void* d_out, int out_size, void* d_ws, size_t ws_size, hipStream_t stream) {
    (void)in_sizes; (void)n_in; (void)out_size;
    if (ws_size < WS_END) return;
    P p{};
    const float* const* in = (const float* const*)d_in;
    p.x = in[0]; p.c = in[1]; p.ada_w = in[2]; p.ada_b = in[3]; p.norm_g = in[4]; p.final_norm_g = in[5];
    p.pool_w_in = in[6]; p.pool_w_grp = in[7]; p.pool_scale = in[8]; p.pool_w_out = in[9];
    p.hgrn_w_in = in[10]; p.hgrn_lb_logits = in[11]; p.hgrn_norm_g = in[12]; p.hgrn_w_out = in[13];
    p.swa_w_in = in[14]; p.swa_sinks = in[15]; p.swa_w_out = in[16];
    p.conv_w_in = in[17]; p.conv_w = in[18]; p.conv_w_out = in[19];
    p.router_w = in[20]; p.router_bias = in[21]; p.moe_w_gate = in[22]; p.moe_w_up = in[23]; p.moe_w_down = in[24];
    p.X = (float*)d_out; p.ws = (unsigned char*)d_ws;
    static int grid = 0;
    if (grid == 0) {
        int dev = 0, cus = 0;
        if (hipGetDevice(&dev) != hipSuccess || hipDeviceGetAttribute(&cus, hipDeviceAttributeMultiprocessorCount, dev) != hipSuccess) { grid = -1; return; }
        if (hipFuncSetAttribute((const void*)mega, hipFuncAttributeMaxDynamicSharedMemorySize, LDS_BYTES) != hipSuccess) { grid = -1; return; }
        grid = (cus >= 256) ? 256 : -1;
    }
    if (grid < 0) return;
    (void)hipMemsetAsync((unsigned char*)d_ws + WS_CTL, 0, CTL_BYTES, stream);
#if MK_ONE_LAUNCH
    hipLaunchKernelGGL(mega, dim3(grid), dim3(NT), LDS_BYTES, stream, p, 0, NPHASE);
#else
    for (int k = 0; k < NPHASE; ++k) hipLaunchKernelGGL(mega, dim3(grid), dim3(NT), LDS_BYTES, stream, p, k, k + 1);
#endif
}
```

```cpp
#include <hip/hip_runtime.h>
#include <stdint.h>

#define LAS __attribute__((address_space(3)))
typedef unsigned short bf16_t;
typedef short bf16x8 __attribute__((ext_vector_type(8)));
typedef float f32x4 __attribute__((ext_vector_type(4)));
typedef unsigned u32x2 __attribute__((ext_vector_type(2)));
typedef float f32x2_t __attribute__((ext_vector_type(2)));
typedef unsigned u32x4 __attribute__((ext_vector_type(4)));

constexpr int D = 1024, NB = 8, SEQ = 4096, M = NB * SEQ, DEPTH = 4;
constexpr int NE = 16, FF = 1024;
constexpr float EPS = 1e-6f;
constexpr int NT = 512, NWV = 8;
constexpr int RCAP = 32768;
constexpr int MAXSLOT = 69632;

constexpr size_t WS_CTL = 0;
constexpr size_t CTL_BYTES = 65536;
constexpr int CW_CNT = 4096;
constexpr size_t WS_MOD = WS_CTL + CTL_BYTES;
constexpr size_t WS_LB = WS_MOD + (size_t)4 * 8 * 6144 * 4;
constexpr size_t WS_TOKINFO = WS_LB + 4096;
constexpr size_t WS_RTOK = WS_TOKINFO + (size_t)M * 16;
constexpr size_t WS_H = WS_RTOK + (size_t)NE * RCAP * 4;
constexpr size_t WS_Z = WS_H + (size_t)M * D * 2;
constexpr size_t WS_O = WS_Z + (size_t)M * D * 2;
constexpr size_t WS_U = WS_O + (size_t)M * D * 2;
constexpr size_t U_BYTES = (size_t)272 << 20;
constexpr size_t WS_ACT = WS_U;
constexpr size_t WS_Y = WS_U + (size_t)MAXSLOT * FF * 2;
constexpr size_t WT_POOL_IN = WS_U + U_BYTES;
constexpr size_t WT_POOL_GRP = WT_POOL_IN + (size_t)1024 * 1024 * 2;
constexpr size_t WT_POOL_OUT = WT_POOL_GRP + (size_t)1024 * 256 * 2;
constexpr size_t WT_HGRN_IN = WT_POOL_OUT + (size_t)1024 * 1024 * 2;
constexpr size_t WT_HGRN_OUT = WT_HGRN_IN + (size_t)4096 * 1024 * 2;
constexpr size_t WT_SWA_IN = WT_HGRN_OUT + (size_t)1024 * 1024 * 2;
constexpr size_t WT_SWA_OUT = WT_SWA_IN + (size_t)1536 * 1024 * 2;
constexpr size_t WT_CONV_IN = WT_SWA_OUT + (size_t)1024 * 1024 * 2;
constexpr size_t WT_CONV_OUT = WT_CONV_IN + (size_t)3072 * 1024 * 2;
constexpr size_t WT_GU = WT_CONV_OUT + (size_t)1024 * 1024 * 2;
constexpr size_t WT_DN = WT_GU + (size_t)64 * 2048 * 1024;
constexpr size_t WT_POOL_W2 = WT_DN + (size_t)64 * 1024 * 1024;
constexpr size_t WS_XB = WT_POOL_W2 + (size_t)1024 * 1024 * 2;
constexpr size_t WS_END = WS_XB + (size_t)M * D * 2;

struct P {
    const float *x, *c, *ada_w, *ada_b, *norm_g, *final_norm_g;
    const float *pool_w_in, *pool_w_grp, *pool_scale, *pool_w_out;
    const float *hgrn_w_in, *hgrn_lb_logits, *hgrn_norm_g, *hgrn_w_out;
    const float *swa_w_in, *swa_sinks, *swa_w_out;
    const float *conv_w_in, *conv_w, *conv_w_out;
    const float *router_w, *router_bias, *moe_w_gate, *moe_w_up, *moe_w_down;
    float* X;
    unsigned char* ws;
};

__device__ __forceinline__ int otid() { int t = threadIdx.x; asm volatile("" : "+v"(t)); return t; }
__device__ __forceinline__ float bf2f(unsigned v) { return __uint_as_float(v << 16); }
__device__ __forceinline__ unsigned f2bf(float f) { unsigned u = __float_as_uint(f); return (u + 0x7fffu + ((u >> 16) & 1u)) >> 16; }
__device__ __forceinline__ unsigned pk2(float lo, float hi) { return f2bf(lo) | (f2bf(hi) << 16); }
__device__ __forceinline__ float bflo(unsigned w) { return __uint_as_float(w << 16); }
__device__ __forceinline__ float bfhi(unsigned w) { return __uint_as_float(w & 0xffff0000u); }
__device__ __forceinline__ float wave_sum(float v) {
#pragma unroll
    for (int o = 1; o < 64; o <<= 1) v += __shfl_xor(v, o);
    return v;
}
__device__ __forceinline__ float sigmoidf_(float x) { return 1.f / (1.f + __expf(-x)); }
__device__ __forceinline__ float siluf_(float x) { return x / (1.f + __expf(-x)); }

__device__ __forceinline__ float sat8(float v) { return __builtin_amdgcn_fmed3f(v, -448.f, 448.f); }
__device__ __forceinline__ unsigned pk8x4(float a, float b, float c, float d) { a = sat8(a); b = sat8(b); c = sat8(c); d = sat8(d); unsigned w = 0; w = __builtin_amdgcn_cvt_pk_fp8_f32(a, b, w, false); w = __builtin_amdgcn_cvt_pk_fp8_f32(c, d, w, true); return w; }
struct ExpGeo { int cnt[NE]; int tstart[NE + 1]; };
__device__ __forceinline__ void load_geo(unsigned* ctl, int layer, ExpGeo& g) {
    int acc = 0;
#pragma unroll
    for (int e = 0; e < NE; ++e) { const int c = (int)__hip_atomic_load(ctl + CW_CNT + (layer * 16 + e) * 64, __ATOMIC_RELAXED, __HIP_MEMORY_SCOPE_AGENT); g.cnt[e] = c; g.tstart[e] = acc; acc += (c + 255) >> 8; }
    g.tstart[NE] = acc;
}

__device__ __forceinline__ void phase_prep(const P& p, int bid, int nblk, float* lds) {
    float* cond = lds;
    float* red = lds + 8 * 1024;
    const int tid = otid(), wave = tid >> 6, lane = tid & 63;
    for (int i = tid; i < NB * D / 4; i += NT) { const f32x4 c4 = ((const f32x4*)p.c)[i]; f32x4 o; o.x = siluf_(c4.x); o.y = siluf_(c4.y); o.z = siluf_(c4.z); o.w = siluf_(c4.w); ((f32x4*)cond)[i] = o; }
    __syncthreads();
    float* mod = (float*)(p.ws + WS_MOD);
    const int nitems = DEPTH * (6 * D / 128);
    for (int it = nblk - 1 - bid; it < nitems; it += nblk) {
        const int l = it / 48, col = (it % 48) * 128 + 2 * lane;
        const float* w = p.ada_w + (size_t)l * D * 6 * D + (size_t)(wave * 128) * 6 * D + col;
        float a0[NB], a1[NB];
#pragma unroll
        for (int b = 0; b < NB; ++b) { a0[b] = 0.f; a1[b] = 0.f; }
        const float* cw = cond + wave * 128;
#pragma unroll 1
        for (int k0 = 0; k0 < 128; k0 += 8) {
            f32x2_t wv[8];
#pragma unroll
            for (int k = 0; k < 8; ++k) wv[k] = *(const f32x2_t*)(w + (size_t)(k0 + k) * 6 * D);
#pragma unroll
            for (int b = 0; b < NB; ++b) {
                const f32x4 c0 = *(const f32x4*)(cw + b * D + k0), c1 = *(const f32x4*)(cw + b * D + k0 + 4);
                a0[b] += (c0.x * wv[0].x + c0.y * wv[1].x) + (c0.z * wv[2].x + c0.w * wv[3].x) + (c1.x * wv[4].x + c1.y * wv[5].x) + (c1.z * wv[6].x + c1.w * wv[7].x);
                a1[b] += (c0.x * wv[0].y + c0.y * wv[1].y) + (c0.z * wv[2].y + c0.w * wv[3].y) + (c1.x * wv[4].y + c1.y * wv[5].y) + (c1.z * wv[6].y + c1.w * wv[7].y);
            }
        }
#pragma unroll
        for (int b = 0; b < NB; ++b) { f32x2_t v = {a0[b], a1[b]}; *(f32x2_t*)(red + (wave * NB + b) * 128 + 2 * lane) = v; }
        __syncthreads();
        {
            const int b = tid >> 6;
            f32x2_t s = {0.f, 0.f};
#pragma unroll
            for (int w2 = 0; w2 < NWV; ++w2) s += *(const f32x2_t*)(red + (w2 * NB + b) * 128 + 2 * lane);
            const f32x2_t bb = *(const f32x2_t*)(p.ada_b + (size_t)l * 6 * D + col);
            *(f32x2_t*)(mod + ((size_t)l * NB + b) * 6 * D + col) = s + bb;
        }
        __syncthreads();
    }
    if (bid == 0) {
        float* lb = (float*)(p.ws + WS_LB);
        for (int d = tid; d < D; d += NT) {
            const float a0 = p.hgrn_lb_logits[d], a1 = p.hgrn_lb_logits[D + d], a2 = p.hgrn_lb_logits[2 * D + d], a3 = p.hgrn_lb_logits[3 * D + d];
            const float mx = fmaxf(fmaxf(a0, a1), fmaxf(a2, a3));
            const float e0 = __expf(a0 - mx), e1 = __expf(a1 - mx), e2 = __expf(a2 - mx), e3 = __expf(a3 - mx);
            lb[d] = e1 / (e0 + e1 + e2 + e3);
        }
    }
}

template <int MODE>
__device__ __forceinline__ void phase_norm(const P& p, int layer, int bid, int nblk, float* lds, int cl = -1, bf16_t* Xo = nullptr) {
    (void)lds; (void)cl;
    bf16_t* Xb = (bf16_t*)(p.ws + WS_XB);
    if (!Xo) Xo = Xb;
    const int tid = otid(), wave = tid >> 6, lane = tid & 63;
    const int NGW = nblk * NWV, gw = bid * NWV + wave;
    const int RPW = M / NGW;
    const float* mod = (const float*)(p.ws + WS_MOD);
    unsigned* ctl = (unsigned*)(p.ws + WS_CTL);
    unsigned char* H = p.ws + WS_H;
    const unsigned char* Y8 = p.ws + WS_Y;
    const u32x4* tokinfo = (const u32x4*)(p.ws + WS_TOKINFO);
    const int row0 = gw * RPW, b = row0 / SEQ;
    const float* ng = (MODE == 2) ? p.final_norm_g : p.norm_g + (size_t)(layer * 2) * D;
    f32x4 gv[4], g2v[4], scv[4], shv[4];
#pragma unroll
    for (int j = 0; j < 4; ++j) {
        gv[j] = *(const f32x4*)(ng + j * 256 + 4 * lane);
        if (MODE == 1 || MODE == 2) g2v[j] = *(const f32x4*)(mod + ((size_t)(layer - 1) * NB + b) * 6 * D + 5 * D + j * 256 + 4 * lane) * 0.125f;
        if (MODE != 2) { const float* sh = mod + ((size_t)layer * NB + b) * 6 * D; shv[j] = *(const f32x4*)(sh + j * 256 + 4 * lane); scv[j] = 1.f + *(const f32x4*)(sh + D + j * 256 + 4 * lane); gv[j] = gv[j] * scv[j]; }
    }
    u32x4 ti_n = {0u, 0u, 0u, 0u};
    f32x4 vx[4]; unsigned y0[4], y1[4]; float w0 = 0.f, w1 = 0.f;
#define NORM_LOAD(R) do { const int r_ = (R); \
        if (MODE == 0) { _Pragma("unroll") for (int j = 0; j < 4; ++j) vx[j] = *(const f32x4*)(p.x + (size_t)r_ * D + j * 256 + 4 * lane); } \
        else { _Pragma("unroll") for (int j = 0; j < 4; ++j) { const u32x2 q = *(const u32x2*)(Xb + (size_t)r_ * D + j * 256 + 4 * lane); vx[j] = (f32x4){bflo(q.x), bfhi(q.x), bflo(q.y), bfhi(q.y)}; } } \
        if (MODE == 1 || MODE == 2) { const u32x4 ti = ti_n; w0 = __uint_as_float(ti.z); w1 = __uint_as_float(ti.w); \
            _Pragma("unroll") for (int j = 0; j < 4; ++j) { y0[j] = *(const unsigned*)(Y8 + (size_t)r_ * 2 * D + j * 256 + 4 * lane); y1[j] = *(const unsigned*)(Y8 + (size_t)r_ * 2 * D + D + j * 256 + 4 * lane); } \
            if (r_ + 1 < row0 + RPW) ti_n = tokinfo[r_ + 1]; } } while (0)
    if (MODE == 1 || MODE == 2) ti_n = tokinfo[row0];
    NORM_LOAD(row0);
    for (int row = row0; row < row0 + RPW; ++row) {
        f32x4 v[4];
#pragma unroll
        for (int j = 0; j < 4; ++j) {
            v[j] = vx[j];
            if (MODE == 1 || MODE == 2) {
                const f32x2_t a0 = __builtin_amdgcn_cvt_pk_f32_fp8(y0[j], false), a1 = __builtin_amdgcn_cvt_pk_f32_fp8(y0[j], true);
                const f32x2_t b0 = __builtin_amdgcn_cvt_pk_f32_fp8(y1[j], false), b1 = __builtin_amdgcn_cvt_pk_f32_fp8(y1[j], true);
                v[j].x += g2v[j].x * (w0 * a0.x + w1 * b0.x);
                v[j].y += g2v[j].y * (w0 * a0.y + w1 * b0.y);
                v[j].z += g2v[j].z * (w0 * a1.x + w1 * b1.x);
                v[j].w += g2v[j].w * (w0 * a1.y + w1 * b1.y);
            }
        }
        if (row + 1 < row0 + RPW) NORM_LOAD(row + 1);
        float ss = 0.f;
#pragma unroll
        for (int j = 0; j < 4; ++j) ss += (v[j].x * v[j].x + v[j].y * v[j].y) + (v[j].z * v[j].z + v[j].w * v[j].w);
        const float rstd = rsqrtf(wave_sum(ss) * (1.f / D) + EPS);
        if (MODE == 2) {
            float* o = ((Xo == Xb) ? p.X : (float*)Xo) + (size_t)row * D;
#pragma unroll
            for (int j = 0; j < 4; ++j) *(f32x4*)(o + j * 256 + 4 * lane) = v[j] * rstd * gv[j];
        } else {
            bf16_t* o = Xo + (size_t)row * D;
#pragma unroll
            for (int j = 0; j < 4; ++j) {
                { u32x2 xw; xw.x = pk2(v[j].x, v[j].y); xw.y = pk2(v[j].z, v[j].w); *(u32x2*)(o + j * 256 + 4 * lane) = xw; }
                const f32x4 h = v[j] * rstd * gv[j] + shv[j];
                const unsigned w = pk8x4(h.x, h.y, h.z, h.w);
                *(unsigned*)(H + (size_t)row * D + j * 256 + 4 * lane) = w;
            }
        }
    }
#undef NORM_LOAD
}

constexpr int N3_WP = 0;
constexpr int N3_RED = 64 * 272;
constexpr int N3_BIAS = N3_RED + 512;
constexpr int N3_LG = N3_BIAS + 16;
constexpr int N3_WCNT = N3_LG + 8 * 272;
constexpr int N3_BBASE = N3_WCNT + 128;
__device__ __forceinline__ void phase_norm3(const P& p, int layer, int bid, int nblk, float* lds, int cl = -1) {
    if (cl < 0) cl = layer;
    const int tid = otid(), wave = tid >> 6, lane = tid & 63, m = lane & 15, kq = lane >> 4;
    const float* mod = (const float*)(p.ws + WS_MOD);
    unsigned* ctl = (unsigned*)(p.ws + WS_CTL);
    unsigned char* H8 = p.ws + WS_H;
    u32x4* tokinfo = (u32x4*)(p.ws + WS_TOKINFO);
    int* rtok = (int*)(p.ws + WS_RTOK);
    const float* ng = p.norm_g + (size_t)(layer * 2 + 1) * D;
    int* wcnt = (int*)(lds + N3_WCNT);
    int* bbase = (int*)(lds + N3_BBASE);
    float rb[NE];
#pragma unroll
    for (int e = 0; e < NE; ++e) rb[e] = p.router_bias[e];
    for (int grp = bid; grp < M / 128; grp += nblk) {
        const int b = (grp * 128) / SEQ;
        const float* sh = mod + ((size_t)layer * NB + b) * 6 * D + 3 * D;
        const float* sc = sh + D;
        {
            float bp[NE];
#pragma unroll
            for (int e = 0; e < NE; ++e) bp[e] = 0.f;
#pragma unroll
            for (int q = 0; q < 2; ++q) {
                const int c = tid + q * NT;
                const float gs = ng[c] * (1.f + sc[c]), shc = sh[c];
                const f32x4 r0 = *(const f32x4*)(p.router_w + c * NE), r1 = *(const f32x4*)(p.router_w + c * NE + 4), r2 = *(const f32x4*)(p.router_w + c * NE + 8), r3 = *(const f32x4*)(p.router_w + c * NE + 12);
                float* dst = lds + N3_WP + ((c >> 6) * 4 + ((c >> 2) & 3)) * 272 + (((c >> 4) & 3) * 4 + (c & 3)) * 16;
                *(f32x4*)(dst) = r0 * gs; *(f32x4*)(dst + 4) = r1 * gs; *(f32x4*)(dst + 8) = r2 * gs; *(f32x4*)(dst + 12) = r3 * gs;
                bp[0] += shc * r0.x; bp[1] += shc * r0.y; bp[2] += shc * r0.z; bp[3] += shc * r0.w; bp[4] += shc * r1.x; bp[5] += shc * r1.y; bp[6] += shc * r1.z; bp[7] += shc * r1.w;
                bp[8] += shc * r2.x; bp[9] += shc * r2.y; bp[10] += shc * r2.z; bp[11] += shc * r2.w; bp[12] += shc * r3.x; bp[13] += shc * r3.y; bp[14] += shc * r3.z; bp[15] += shc * r3.w;
            }
#pragma unroll
            for (int e = 0; e < NE; ++e) {
#pragma unroll
                for (int o = 1; o < 64; o <<= 1) bp[e] += __shfl_xor(bp[e], o);
            }
            if (lane == 0) {
#pragma unroll
                for (int e = 0; e < NE; ++e) lds[N3_RED + wave * 16 + e] = bp[e];
            }
        }
        __syncthreads();
        if (tid < NE) { float s = 0.f;
#pragma unroll
            for (int q = 0; q < NWV; ++q) s += lds[N3_RED + q * 16 + tid];
            lds[N3_BIAS + tid] = s; }
        __syncthreads();
        const int R0 = grp * 128 + wave * 16;
        const bf16_t* xr = (const bf16_t*)(p.ws + WS_XB) + (size_t)(R0 + m) * D + 4 * kq;
        f32x4 d0 = {0.f, 0.f, 0.f, 0.f}, d1 = {0.f, 0.f, 0.f, 0.f};
        float ss = 0.f;
        u32x2 xs[8][4];
#pragma unroll
        for (int s = 0; s < 8; ++s)
#pragma unroll
            for (int j = 0; j < 4; ++j) xs[s][j] = *(const u32x2*)(xr + s * 64 + 16 * j);
        float wv[2][16];
        { const float* wp = lds + N3_WP + kq * 272 + m;
#pragma unroll
          for (int i = 0; i < 16; ++i) wv[0][i] = wp[i * 16]; }
#pragma unroll
        for (int ch = 0; ch < 16; ++ch) {
            u32x2 q[4];
#pragma unroll
            for (int j = 0; j < 4; ++j) q[j] = xs[ch & 7][j];
            if (ch + 8 < 16) {
#pragma unroll
                for (int j = 0; j < 4; ++j) xs[ch & 7][j] = *(const u32x2*)(xr + (ch + 8) * 64 + 16 * j);
            }
            if (ch + 1 < 16) { const float* wp = lds + N3_WP + ((ch + 1) * 4 + kq) * 272 + m;
#pragma unroll
                for (int i = 0; i < 16; ++i) wv[(ch + 1) & 1][i] = wp[i * 16]; }
#pragma unroll
            for (int j = 0; j < 4; ++j) {
                const f32x4 xv = (f32x4){bflo(q[j].x), bfhi(q[j].x), bflo(q[j].y), bfhi(q[j].y)};
                ss += (xv.x * xv.x + xv.y * xv.y) + (xv.z * xv.z + xv.w * xv.w);
                d0 = __builtin_amdgcn_mfma_f32_16x16x4f32(xv.x, wv[ch & 1][4 * j + 0], d0, 0, 0, 0);
                d1 = __builtin_amdgcn_mfma_f32_16x16x4f32(xv.y, wv[ch & 1][4 * j + 1], d1, 0, 0, 0);
                d0 = __builtin_amdgcn_mfma_f32_16x16x4f32(xv.z, wv[ch & 1][4 * j + 2], d0, 0, 0, 0);
                d1 = __builtin_amdgcn_mfma_f32_16x16x4f32(xv.w, wv[ch & 1][4 * j + 3], d1, 0, 0, 0);
            }
        }
        ss += __shfl_xor(ss, 16); ss += __shfl_xor(ss, 32);
        const float rstd = rsqrtf(ss * (1.f / D) + EPS);
        {
            const f32x4 d = d0 + d1; const float be = lds[N3_BIAS + m];
            float* lg = lds + N3_LG + wave * 272;
#pragma unroll
            for (int i = 0; i < 4; ++i) { const float rs = __shfl(rstd, 4 * kq + i); lg[(4 * kq + i) * 17 + m] = rs * d[i] + be; }
        }
        asm volatile("s_waitcnt lgkmcnt(0)" ::: "memory");
        int my_e0 = -1, my_e1 = -1, my_row = -1; float my_w0 = 0.f, my_w1 = 0.f;
        {
            float lgt[NE];
            const float* lg = lds + N3_LG + wave * 272 + m * 17;
#pragma unroll
            for (int e = 0; e < NE; ++e) lgt[e] = lg[e];
                float sc_[NE], sel[NE];
#pragma unroll
                for (int e = 0; e < NE; ++e) { const float lg = lgt[e]; sc_[e] = sigmoidf_(lg); sel[e] = sc_[e] + rb[e]; }
                float gs[4];
#pragma unroll
                for (int g = 0; g < 4; ++g) {
                    const float a = sel[4 * g], b2 = sel[4 * g + 1], c2 = sel[4 * g + 2], d2 = sel[4 * g + 3];
                    const float hi1 = fmaxf(a, b2), lo1 = fminf(a, b2), hi2 = fmaxf(c2, d2), lo2 = fminf(c2, d2);
                    gs[g] = fmaxf(hi1, hi2) + fmaxf(fminf(hi1, hi2), fmaxf(lo1, lo2));
                }
                int best = 0; float bs = gs[0];
#pragma unroll
                for (int g = 1; g < 4; ++g) if (gs[g] > bs) { bs = gs[g]; best = g; }
                float s4[4], p4[4];
#pragma unroll
                for (int i = 0; i < 4; ++i) {
                    s4[i] = best == 0 ? sel[i] : best == 1 ? sel[4 + i] : best == 2 ? sel[8 + i] : sel[12 + i];
                    p4[i] = best == 0 ? sc_[i] : best == 1 ? sc_[4 + i] : best == 2 ? sc_[8 + i] : sc_[12 + i];
                }
                int i0 = 0; float m0 = s4[0], q0 = p4[0];
#pragma unroll
                for (int i = 1; i < 4; ++i) if (s4[i] > m0) { m0 = s4[i]; i0 = i; q0 = p4[i]; }
                int i1 = -1; float m1 = -INFINITY, q1 = 0.f;
#pragma unroll
                for (int i = 0; i < 4; ++i) if (i != i0 && s4[i] > m1) { m1 = s4[i]; i1 = i; q1 = p4[i]; }
            const float inv = 1.f / (q0 + q1);
            if (lane < 16) { my_e0 = best * 4 + i0; my_e1 = best * 4 + i1; my_w0 = q0 * inv; my_w1 = q1 * inv; my_row = R0 + lane; }
        }
        {
            f32x4 gsv[4], shv[4];
#pragma unroll
            for (int j = 0; j < 4; ++j) { const f32x4 g4 = *(const f32x4*)(ng + j * 256 + 4 * lane), s1 = *(const f32x4*)(sc + j * 256 + 4 * lane); gsv[j] = g4 * (1.f + s1); shv[j] = *(const f32x4*)(sh + j * 256 + 4 * lane); }
            const bf16_t* xq = (const bf16_t*)(p.ws + WS_XB) + (size_t)R0 * D;
            u32x2 qn[4];
#pragma unroll
            for (int j = 0; j < 4; ++j) qn[j] = *(const u32x2*)(xq + j * 256 + 4 * lane);
#pragma unroll 2
            for (int r = 0; r < 16; ++r) {
                const float rs = __shfl(rstd, r);
                u32x2 q[4];
#pragma unroll
                for (int j = 0; j < 4; ++j) q[j] = qn[j];
                if (r + 1 < 16) {
#pragma unroll
                    for (int j = 0; j < 4; ++j) qn[j] = *(const u32x2*)(xq + (size_t)(r + 1) * D + j * 256 + 4 * lane); }
#pragma unroll
                for (int j = 0; j < 4; ++j) { const f32x4 hq = (f32x4){bflo(q[j].x), bfhi(q[j].x), bflo(q[j].y), bfhi(q[j].y)} * rs * gsv[j] + shv[j];
                    const unsigned w = pk8x4(hq.x, hq.y, hq.z, hq.w);
                    *(unsigned*)(H8 + (size_t)(R0 + r) * D + j * 256 + 4 * lane) = w; }
            }
        }
        const unsigned long long lt = (1ull << lane) - 1ull;
        int mycount = 0;
#pragma unroll
        for (int e = 0; e < NE; ++e) {
            const unsigned long long m0 = __ballot(my_e0 == e), m1 = __ballot(my_e1 == e);
            const int c = __popcll(m0) + __popcll(m1);
            if (lane == e) mycount = c;
        }
        if (lane < NE) wcnt[wave * NE + lane] = mycount;
        __syncthreads();
        if (tid < NE) {
            int tot = 0;
#pragma unroll
            for (int w2 = 0; w2 < NWV; ++w2) tot += wcnt[w2 * NE + tid];
            bbase[tid] = (cl >= 8) ? 0 : (int)atomicAdd(ctl + CW_CNT + (cl * 16 + tid) * 64, (unsigned)tot);
        }
        __syncthreads();
        int pos0 = 0, pos1 = 0;
#pragma unroll
        for (int e = 0; e < NE; ++e) {
            int be = bbase[e];
            for (int w2 = 0; w2 < wave; ++w2) be += wcnt[w2 * NE + e];
            const unsigned long long m0 = __ballot(my_e0 == e), m1 = __ballot(my_e1 == e);
            if (my_e0 == e) pos0 = be + __popcll(m0 & lt);
            if (my_e1 == e) pos1 = be + __popcll(m0) + __popcll(m1 & lt);
        }
        if (my_row >= 0) {
            rtok[my_e0 * RCAP + pos0] = my_row * 2; rtok[my_e1 * RCAP + pos1] = my_row * 2 + 1;
            u32x4 ti; ti.x = ((unsigned)my_e0 << 16) | (unsigned)pos0; ti.y = ((unsigned)my_e1 << 16) | (unsigned)pos1; ti.z = __float_as_uint(my_w0); ti.w = __float_as_uint(my_w1);
            tokinfo[my_row] = ti;
        }
        __syncthreads();
    }
}

__device__ __forceinline__ void phase_pool(const P& p, int bid, int nblk) {
    const bf16_t* U0 = (const bf16_t*)(p.ws + WS_U);
    bf16_t* P0 = (bf16_t*)(p.ws + WS_U + ((size_t)64 << 20));
    const int nitem = 128 * (M / 32);
    for (int it = bid * NT + otid(); it < nitem; it += nblk * NT) {
        const int ch = it & 127, seg = it >> 7;
        const int col = ch * 8, g = col >> 8, w = 2 << g;
        const int t0 = seg * 32, tb = t0 & (SEQ - 1);
        float s[8];
#pragma unroll
        for (int i = 0; i < 8; ++i) s[i] = 0.f;
        for (int i = 1; i < w; ++i) if (tb - i >= 0) {
            const u32x4 v = *(const u32x4*)(U0 + (size_t)(t0 - i) * D + col);
            s[0] += bflo(v.x); s[1] += bfhi(v.x); s[2] += bflo(v.y); s[3] += bfhi(v.y); s[4] += bflo(v.z); s[5] += bfhi(v.z); s[6] += bflo(v.w); s[7] += bfhi(v.w);
        }
        const u32x4 zero4 = {0u, 0u, 0u, 0u};
        u32x4 vn = *(const u32x4*)(U0 + (size_t)t0 * D + col);
        u32x4 qn = (tb - w + 1 >= 0) ? *(const u32x4*)(U0 + (size_t)(t0 - w + 1) * D + col) : zero4;
        for (int r = 0; r < 32; ++r) {
            const int t = t0 + r, tp = tb + r;
            const u32x4 v = vn, q = qn;
            if (r + 1 < 32) { vn = *(const u32x4*)(U0 + (size_t)(t + 1) * D + col); qn = (tp + 2 - w >= 0) ? *(const u32x4*)(U0 + (size_t)(t + 2 - w) * D + col) : zero4; }
            float u[8] = {bflo(v.x), bfhi(v.x), bflo(v.y), bfhi(v.y), bflo(v.z), bfhi(v.z), bflo(v.w), bfhi(v.w)};
            const float inv = 1.f / (float)(tp + 1 < w ? tp + 1 : w);
            float o[8];
#pragma unroll
            for (int i = 0; i < 8; ++i) { s[i] += u[i]; o[i] = s[i] * inv - u[i]; }
            u32x4 ov; ov.x = pk2(o[0], o[1]); ov.y = pk2(o[2], o[3]); ov.z = pk2(o[4], o[5]); ov.w = pk2(o[6], o[7]);
            *(u32x4*)(P0 + (size_t)t * D + col) = ov;
            s[0] -= bflo(q.x); s[1] -= bfhi(q.x); s[2] -= bflo(q.y); s[3] -= bfhi(q.y); s[4] -= bflo(q.z); s[5] -= bfhi(q.z); s[6] -= bflo(q.w); s[7] -= bfhi(q.w);
        }
    }
}

__device__ __forceinline__ void phase_hgrn_gate(const P& p, int bid, int nblk) {
    const int tid = otid(), wave = tid >> 6, lane = tid & 63;
    const int NGW = nblk * NWV, RPW = M / NGW, row0 = (bid * NWV + wave) * RPW;
    const bf16_t* O = (const bf16_t*)(p.ws + WS_O);
    const bf16_t* U1 = (const bf16_t*)(p.ws + WS_U);
    unsigned char* Z = p.ws + WS_Z;
    float ngv[16];
#pragma unroll
    for (int i = 0; i < 16; ++i) ngv[i] = p.hgrn_norm_g[(lane & 7) * 16 + i];
    u32x4 a0, a1, g0, g1;
#define GATE_LOAD(R) do { const size_t r_ = (size_t)(R); a0 = *(const u32x4*)(O + r_ * D + lane * 16); a1 = *(const u32x4*)(O + r_ * D + lane * 16 + 8); \
        g0 = *(const u32x4*)(U1 + r_ * 4096 + 3072 + lane * 16); g1 = *(const u32x4*)(U1 + r_ * 4096 + 3072 + lane * 16 + 8); } while (0)
    GATE_LOAD(row0);
    for (int row = row0; row < row0 + RPW; ++row) {
        float o[16] = {bflo(a0.x), bfhi(a0.x), bflo(a0.y), bfhi(a0.y), bflo(a0.z), bfhi(a0.z), bflo(a0.w), bfhi(a0.w),
                       bflo(a1.x), bfhi(a1.x), bflo(a1.y), bfhi(a1.y), bflo(a1.z), bfhi(a1.z), bflo(a1.w), bfhi(a1.w)};
        float sg[16] = {bflo(g0.x), bfhi(g0.x), bflo(g0.y), bfhi(g0.y), bflo(g0.z), bfhi(g0.z), bflo(g0.w), bfhi(g0.w),
                        bflo(g1.x), bfhi(g1.x), bflo(g1.y), bfhi(g1.y), bflo(g1.z), bfhi(g1.z), bflo(g1.w), bfhi(g1.w)};
        if (row + 1 < row0 + RPW) GATE_LOAD(row + 1);
        float ss = 0.f;
#pragma unroll
        for (int i = 0; i < 16; ++i) ss += o[i] * o[i];
        ss += __shfl_xor(ss, 1); ss += __shfl_xor(ss, 2); ss += __shfl_xor(ss, 4);
        const float rstd = rsqrtf(ss * (1.f / 128.f) + EPS);
        float z[16];
#pragma unroll
        for (int i = 0; i < 16; ++i) z[i] = o[i] * (rstd * 8.f) * ngv[i] * sg[i];
        u32x4 z0; z0.x = pk8x4(z[0], z[1], z[2], z[3]); z0.y = pk8x4(z[4], z[5], z[6], z[7]); z0.z = pk8x4(z[8], z[9], z[10], z[11]); z0.w = pk8x4(z[12], z[13], z[14], z[15]);
        *(u32x4*)(Z + (size_t)row * D + lane * 16) = z0;
    }
#undef GATE_LOAD
}

__device__ __forceinline__ void phase_conv(const P& p, int bid, int nblk) {
    const bf16_t* Bg = (const bf16_t*)(p.ws + WS_U);
    const bf16_t* CU = (const bf16_t*)(p.ws + WS_U + ((size_t)64 << 20));
    unsigned char* Z = p.ws + WS_Z;
    const int nitem = M * 128, step = nblk * NT;
    int it = bid * NT + otid();
    if (it >= nitem) return;
    const int col = (it & 127) * 8;
    f32x4 cw[3][2];
#pragma unroll
    for (int j = 0; j < 3; ++j) { cw[j][0] = *(const f32x4*)(p.conv_w + j * D + col); cw[j][1] = *(const f32x4*)(p.conv_w + j * D + col + 4); }
    u32x4 c0, c1, c2, bv;
#define CONV_LOAD(IT) do { const int t_ = (IT) >> 7, tp_ = t_ & (SEQ - 1); const u32x4 z_ = {0u, 0u, 0u, 0u}; \
        c0 = (tp_ >= 2) ? *(const u32x4*)(CU + (size_t)(t_ - 2) * D + col) : z_; c1 = (tp_ >= 1) ? *(const u32x4*)(CU + (size_t)(t_ - 1) * D + col) : z_; \
        c2 = *(const u32x4*)(CU + (size_t)t_ * D + col); bv = *(const u32x4*)(Bg + (size_t)t_ * D + col); } while (0)
    CONV_LOAD(it);
    for (;;) {
        const u32x4 a0 = c0, a1 = c1, a2 = c2, ab = bv; const int t = it >> 7;
        const int nx = it + step; const bool more = nx < nitem;
        if (more) CONV_LOAD(nx);
        float acc[8];
        acc[0] = cw[0][0].x * bflo(a0.x) + cw[1][0].x * bflo(a1.x) + cw[2][0].x * bflo(a2.x); acc[1] = cw[0][0].y * bfhi(a0.x) + cw[1][0].y * bfhi(a1.x) + cw[2][0].y * bfhi(a2.x);
        acc[2] = cw[0][0].z * bflo(a0.y) + cw[1][0].z * bflo(a1.y) + cw[2][0].z * bflo(a2.y); acc[3] = cw[0][0].w * bfhi(a0.y) + cw[1][0].w * bfhi(a1.y) + cw[2][0].w * bfhi(a2.y);
        acc[4] = cw[0][1].x * bflo(a0.z) + cw[1][1].x * bflo(a1.z) + cw[2][1].x * bflo(a2.z); acc[5] = cw[0][1].y * bfhi(a0.z) + cw[1][1].y * bfhi(a1.z) + cw[2][1].y * bfhi(a2.z);
        acc[6] = cw[0][1].z * bflo(a0.w) + cw[1][1].z * bflo(a1.w) + cw[2][1].z * bflo(a2.w); acc[7] = cw[0][1].w * bfhi(a0.w) + cw[1][1].w * bfhi(a1.w) + cw[2][1].w * bfhi(a2.w);
        u32x2 o; o.x = pk8x4(acc[0] * bflo(ab.x) * 8.f, acc[1] * bfhi(ab.x) * 8.f, acc[2] * bflo(ab.y) * 8.f, acc[3] * bfhi(ab.y) * 8.f);
        o.y = pk8x4(acc[4] * bflo(ab.z) * 8.f, acc[5] * bfhi(ab.z) * 8.f, acc[6] * bflo(ab.w) * 8.f, acc[7] * bfhi(ab.w) * 8.f);
        *(u32x2*)(Z + (size_t)t * D + col) = o;
        if (!more) break;
        it = nx;
    }
#undef CONV_LOAD
}

namespace pg8 {
constexpr int BM = 256, BK = 64, HALF = 128, HTB = HALF * BK * 2, STAGE_BYTES = 8 * HTB;
__device__ __forceinline__ int lds_byte(int r, int c) { const int st = (r >> 4) * 2 + (c >> 5), rr = r & 15, cc = c & 31, ob = rr * 64 + cc * 2; return st * 1024 + (ob ^ (((ob >> 9) & 1) << 5)); }
__device__ __forceinline__ void stage_rc(int b, int& R, int& C) { const int st = b / 1024, sb = b % 1024, swz = sb ^ (((sb >> 9) & 1) << 5); R = (st >> 1) * 16 + swz / 64; C = (st & 1) * 32 + (swz % 64) / 2; }
__device__ __forceinline__ int perm32(int rho) { const int n = rho >> 4, i = rho & 15; return 8 * (i >> 2) + 4 * n + (i & 3); }
struct Unit { int pm, pn, e, ui; };
typedef f32x4 Acc[2][2][4][2];

struct DenseProb {
    static constexpr int esz = 2;
    const bf16_t* A; const bf16_t* Bt; int lda, ldb, acol_pn, nM, nN, G, c;
    __device__ __forceinline__ bool next(int i, Unit& u) const { const int l = i * (G >> 3) + (c >> 3), rr = l / nN; u.pn = l - rr * nN; u.pm = rr * 8 + (c & 7); u.e = 0; u.ui = i; return u.pm < nM; }
    __device__ __forceinline__ void a_off(const Unit& u, const int (&R)[2], const int (&C)[2], unsigned (&off)[2][2]) const {
#pragma unroll
        for (int h = 0; h < 2; ++h)
#pragma unroll
            for (int i = 0; i < 2; ++i) off[h][i] = (unsigned)((u.pm * 256 + h * 128 + R[i]) * lda + u.pn * acol_pn + C[i]) * 2u;
    }
    __device__ __forceinline__ const char* a_base() const { return (const char*)A; }
    __device__ __forceinline__ const char* b_base(const Unit& u) const { return (const char*)Bt + (size_t)u.pn * 256 * ldb * 2; }
};
struct DenseProb8 {
    static constexpr int esz = 1;
    const unsigned char* A; const unsigned char* Bt; int lda, ldb, nM, nN, G, c, sa, sb;
    __device__ __forceinline__ bool next(int i, Unit& u) const { const int l = i * (G >> 3) + (c >> 3), rr = l / nN; u.pn = l - rr * nN; u.pm = rr * 8 + (c & 7); u.e = 0; u.ui = i; return u.pm < nM; }
    __device__ __forceinline__ void a_off(const Unit& u, const int (&R)[2], const int (&C)[2], unsigned (&off)[2][2]) const {
#pragma unroll
        for (int h = 0; h < 2; ++h)
#pragma unroll
            for (int i = 0; i < 2; ++i) off[h][i] = (unsigned)((u.pm * 256 + h * 128 + R[i]) * lda + 2 * C[i]);
    }
    __device__ __forceinline__ const char* a_base() const { return (const char*)A; }
    __device__ __forceinline__ const char* b_base(const Unit& u) const { return (const char*)Bt + (size_t)u.pn * 256 * ldb; }
};
struct MoeProb {
    static constexpr int esz = 1;
    const unsigned char* A; const unsigned char* Bt; size_t bstride; const int* rtok; const LAS int* geo; const LAS unsigned* rowtab; int lda, ldb, nN, G, c, gather, sa, sb;
    __device__ __forceinline__ bool next(int i, Unit& u) const {
        const int RT = geo[NE], npx = (RT + 7) >> 3;
        const int l = i * (G >> 3) + (c >> 3), rr = l / nN; u.pn = l - rr * nN; u.pm = (c & 7) * npx + rr; u.ui = i;
        int e = 0;
#pragma unroll
        for (int k = 1; k < NE; ++k) e += (u.pm >= geo[k]) ? 1 : 0;
        u.e = e; return rr < npx && u.pm < RT;
    }
    template <int SCAT, int NU> __device__ __forceinline__ void fill_rowtab(LAS unsigned* tab, int tid) const {
        if (tid < 256) {
            int tok[NU];
#pragma unroll
            for (int i = 0; i < NU; ++i) { Unit u; const bool ok = next(i, u); const int pos = (u.pm - geo[u.e]) * 256 + tid, cnt = geo[NE + 1 + u.e]; tok[i] = (ok && pos < cnt) ? rtok[u.e * RCAP + pos] : (SCAT ? 2 * M + tid : 0); }
#pragma unroll
            for (int i = 0; i < NU; ++i) tab[i * 256 + tid] = SCAT ? (unsigned)tok[i] * (unsigned)D : (unsigned)((tok[i] >> 1) * lda);
        }
    }
    __device__ __forceinline__ void a_off(const Unit& u, const int (&R)[2], const int (&C)[2], unsigned (&off)[2][2]) const {
        if (gather) {
#pragma unroll
            for (int h = 0; h < 2; ++h)
#pragma unroll
                for (int i = 0; i < 2; ++i) off[h][i] = rowtab[u.ui * 256 + h * 128 + R[i]] + (unsigned)(2 * C[i]);
        } else {
#pragma unroll
            for (int h = 0; h < 2; ++h)
#pragma unroll
                for (int i = 0; i < 2; ++i) off[h][i] = (unsigned)((u.pm * 256 + h * 128 + R[i]) * lda + 2 * C[i]);
        }
    }
    __device__ __forceinline__ const char* a_base() const { return (const char*)A; }
    __device__ __forceinline__ const char* b_base(const Unit& u) const { return (const char*)Bt + ((size_t)u.e * bstride + (size_t)u.pn * 256 * ldb); }
};

__device__ __forceinline__ unsigned cvt_pk_bf16(float lo, float hi) { unsigned r; asm volatile("v_cvt_pk_bf16_f32 %0, %1, %2" : "=v"(r) : "v"(lo), "v"(hi)); return r; }
__device__ __forceinline__ u32x4 pack8(const f32x4 v0, const f32x4 v1) { u32x4 w; w.x = cvt_pk_bf16(v0[0], v0[1]); w.y = cvt_pk_bf16(v0[2], v0[3]); w.z = cvt_pk_bf16(v1[0], v1[1]); w.w = cvt_pk_bf16(v1[2], v1[3]); return w; }
__device__ __forceinline__ float sigm(float x) { return __builtin_amdgcn_rcpf(1.f + __expf(-x)); }
__device__ __forceinline__ f32x4 silu4(f32x4 v) { f32x4 o; o[0] = v[0] * sigm(v[0]); o[1] = v[1] * sigm(v[1]); o[2] = v[2] * sigm(v[2]); o[3] = v[3] * sigm(v[3]); return o; }

__device__ __forceinline__ unsigned pk_fp8x4(float a, float b, float c, float d) { return pk8x4(a, b, c, d); }
#define ST16(ptr, val) (*(u32x4*)(ptr) = (val))
struct EpPlain { static constexpr bool PERM = true; static constexpr int NST = 16; bf16_t* C; const float* colscale; int ldc; float s0; int s0_pn; float s1;
    __device__ __forceinline__ void operator()(const Acc& acc, const Unit& u, int wr, int wc, int fr, int fq) const {
        const int row0 = u.pm * BM + wr * 64 + fr, col0 = u.pn * BM + wc * 32 + 8 * fq;
        const float sc = (u.pn < s0_pn) ? s0 : s1;
        f32x4 cs[2][2];
#pragma unroll
        for (int bj = 0; bj < 2; ++bj)
#pragma unroll
            for (int n = 0; n < 2; ++n) cs[bj][n] = colscale ? *(const f32x4*)(colscale + col0 + bj * HALF + 4 * n) * sc : (f32x4){sc, sc, sc, sc};
#pragma unroll
        for (int ai = 0; ai < 2; ++ai)
#pragma unroll
            for (int m = 0; m < 4; ++m) { bf16_t* rowp = C + (size_t)(row0 + ai * HALF + m * 16) * ldc + col0;
#pragma unroll
                for (int bj = 0; bj < 2; ++bj) ST16(rowp + bj * HALF, pack8(acc[ai][bj][m][0] * cs[bj][0], acc[ai][bj][m][1] * cs[bj][1])); }
    }
};
struct EpHgrnIn { static constexpr bool PERM = true; static constexpr int NST = 16; bf16_t* C; const float* lb;
    __device__ __forceinline__ void operator()(const Acc& acc, const Unit& u, int wr, int wc, int fr, int fq) const {
        const int row0 = u.pm * BM + wr * 64 + fr, col0 = u.pn * BM + wc * 32 + 8 * fq, kind = u.pn >> 2;
        f32x4 om[2][2];
#pragma unroll
        for (int bj = 0; bj < 2; ++bj)
#pragma unroll
            for (int n = 0; n < 2; ++n) om[bj][n] = (kind == 1) ? (1.f - *(const f32x4*)(lb + (col0 - 1024) + bj * HALF + 4 * n)) : (f32x4){0.f, 0.f, 0.f, 0.f};
#pragma unroll
        for (int ai = 0; ai < 2; ++ai)
#pragma unroll
            for (int m = 0; m < 4; ++m) { bf16_t* rowp = C + (size_t)(row0 + ai * HALF + m * 16) * 4096 + col0;
#pragma unroll
                for (int bj = 0; bj < 2; ++bj) { f32x4 v0 = acc[ai][bj][m][0] * 0.03125f, v1 = acc[ai][bj][m][1] * 0.03125f;
                    if (kind == 0 || kind == 3) { v0 = silu4(v0); v1 = silu4(v1); }
                    else if (kind == 1) { f32x4 a, b; a[0] = sigm(-v0[0]); a[1] = sigm(-v0[1]); a[2] = sigm(-v0[2]); a[3] = sigm(-v0[3]); b[0] = sigm(-v1[0]); b[1] = sigm(-v1[1]); b[2] = sigm(-v1[2]); b[3] = sigm(-v1[3]);
                        v0 = a * om[bj][0]; v1 = b * om[bj][1]; }
                    ST16(rowp + bj * HALF, pack8(v0, v1)); } }
    }
};
struct EpConvIn { static constexpr bool PERM = true; static constexpr int NST = 8; bf16_t* Bg; bf16_t* CU;
    __device__ __forceinline__ void operator()(const Acc& acc, const Unit& u, int wr, int wc, int fr, int fq) const {
        const int row0 = u.pm * BM + wr * 64 + fr;
        if (u.pn < 4) {
            const int col0 = u.pn * BM + wc * 32 + 8 * fq;
#pragma unroll
            for (int ai = 0; ai < 2; ++ai)
#pragma unroll
                for (int m = 0; m < 4; ++m) { bf16_t* rowp = Bg + (size_t)(row0 + ai * HALF + m * 16) * D + col0;
#pragma unroll
                    for (int bj = 0; bj < 2; ++bj) ST16(rowp + bj * HALF, pack8(acc[ai][bj][m][0] * 0.03125f, acc[ai][bj][m][1] * 0.03125f)); }
        } else {
            const int col0 = (u.pn - 4) * HALF + wc * 32 + 8 * fq;
#pragma unroll
            for (int ai = 0; ai < 2; ++ai)
#pragma unroll
                for (int m = 0; m < 4; ++m) ST16(CU + (size_t)(row0 + ai * HALF + m * 16) * D + col0, pack8(acc[ai][0][m][0] * acc[ai][1][m][0] * (1.f / 1024.f), acc[ai][0][m][1] * acc[ai][1][m][1] * (1.f / 1024.f)));
        }
    }
};
struct EpSwiGlu { static constexpr bool PERM = true; static constexpr int NST = 4; unsigned char* ACT;
    __device__ __forceinline__ void operator()(const Acc& acc, const Unit& u, int wr, int wc, int fr, int fq) const {
        const int row0 = u.pm * BM + wr * 64 + fr + (fq & 1) * 16, col0 = u.pn * HALF + wc * 32 + 8 * (fq & 2);
#pragma unroll
        for (int ai = 0; ai < 2; ++ai)
#pragma unroll
            for (int mp = 0; mp < 2; ++mp) {
                u32x2 w[2];
#pragma unroll
                for (int q = 0; q < 2; ++q) { const int m = 2 * mp + q;
                    const f32x4 v0 = silu4(acc[ai][0][m][0] * 0.03125f) * acc[ai][1][m][0] * 0.25f, v1 = silu4(acc[ai][0][m][1] * 0.03125f) * acc[ai][1][m][1] * 0.25f;
                    w[q].x = pk_fp8x4(v0[0], v0[1], v0[2], v0[3]); w[q].y = pk_fp8x4(v1[0], v1[1], v1[2], v1[3]); }
                const auto rx = __builtin_amdgcn_permlane16_swap(w[0].x, w[1].x, false, false), ry = __builtin_amdgcn_permlane16_swap(w[0].y, w[1].y, false, false);
                u32x4 o; o.x = rx[0]; o.y = ry[0]; o.z = rx[1]; o.w = ry[1];
                *(u32x4*)(ACT + (size_t)(row0 + ai * HALF + mp * 32) * FF + col0) = o; }
    }
};
struct EpY8 { static constexpr bool PERM = true; static constexpr int NST = 8; unsigned char* Y; const LAS unsigned* rowtab;
    __device__ __forceinline__ void operator()(const Acc& acc, const Unit& u, int wr, int wc, int fr, int fq) const {
        const int col0 = u.pn * BM + wc * 32 + 8 * (fq & 2) + (fq & 1) * HALF;
        unsigned ro[2][4];
#pragma unroll
        for (int ai = 0; ai < 2; ++ai)
#pragma unroll
            for (int m = 0; m < 4; ++m) ro[ai][m] = rowtab[u.ui * 256 + ai * HALF + wr * 64 + m * 16 + fr];
#pragma unroll
        for (int ai = 0; ai < 2; ++ai)
#pragma unroll
            for (int m = 0; m < 4; ++m) {
                u32x2 w[2];
#pragma unroll
                for (int bj = 0; bj < 2; ++bj) { const f32x4 v0 = acc[ai][bj][m][0] * 0.03125f, v1 = acc[ai][bj][m][1] * 0.03125f;
                    w[bj].x = pk_fp8x4(v0[0], v0[1], v0[2], v0[3]); w[bj].y = pk_fp8x4(v1[0], v1[1], v1[2], v1[3]); }
                const auto rx = __builtin_amdgcn_permlane16_swap(w[0].x, w[1].x, false, false), ry = __builtin_amdgcn_permlane16_swap(w[0].y, w[1].y, false, false);
                u32x4 o; o.x = rx[0]; o.y = ry[0]; o.z = rx[1]; o.w = ry[1];
                *(u32x4*)(Y + (size_t)ro[ai][m] + col0) = o; }
    }
};
struct EpResid { static constexpr bool PERM = true; static constexpr int NST = 16; const bf16_t* X; const float* g1; bf16_t* Xo; float s; int pad_;
    __device__ __forceinline__ void operator()(const Acc& acc, const Unit& u, int wr, int wc, int fr, int fq) const {
        const int row0 = u.pm * BM + wr * 64 + fr, col0 = u.pn * BM + wc * 32 + 8 * fq;
        const float* gb = g1 + (size_t)(u.pm >> 4) * 6 * D;
        f32x4 gv[2][2];
#pragma unroll
        for (int bj = 0; bj < 2; ++bj)
#pragma unroll
            for (int n = 0; n < 2; ++n) gv[bj][n] = *(const f32x4*)(gb + col0 + bj * HALF + 4 * n) * s;
        u32x4 xn[2];
        { const size_t ro = (size_t)row0 * D + col0; xn[0] = *(const u32x4*)(X + ro); xn[1] = *(const u32x4*)(X + ro + HALF); }
#pragma unroll
        for (int q = 0; q < 8; ++q) {
            const int ai = q >> 2, m = q & 3;
            const size_t ro = (size_t)(row0 + ai * HALF + m * 16) * D + col0;
            const u32x4 xq0 = xn[0], xq1 = xn[1];
            if (q + 1 < 8) { const size_t rn = (size_t)(row0 + ((q + 1) >> 2) * HALF + ((q + 1) & 3) * 16) * D + col0; xn[0] = *(const u32x4*)(X + rn); xn[1] = *(const u32x4*)(X + rn + HALF); }
#pragma unroll
            for (int bj = 0; bj < 2; ++bj) { const u32x4 xq = bj ? xq1 : xq0;
                f32x4 x0 = {__uint_as_float(xq.x << 16), __uint_as_float(xq.x & 0xffff0000u), __uint_as_float(xq.y << 16), __uint_as_float(xq.y & 0xffff0000u)};
                f32x4 x1 = {__uint_as_float(xq.z << 16), __uint_as_float(xq.z & 0xffff0000u), __uint_as_float(xq.w << 16), __uint_as_float(xq.w & 0xffff0000u)};
                ST16(Xo + ro + bj * HALF, pack8(x0 + gv[bj][0] * acc[ai][bj][m][0], x1 + gv[bj][1] * acc[ai][bj][m][1])); }
            asm volatile("" ::: "memory");
        }
    }
};

typedef int i32x4v __attribute__((ext_vector_type(4)));
typedef int i32x8v __attribute__((ext_vector_type(8)));
template <class P_> __device__ __forceinline__ int prob_sa(const P_& S) { if constexpr (P_::esz == 1) return S.sa; else return 127; }
template <class P_> __device__ __forceinline__ int prob_sb(const P_& S) { if constexpr (P_::esz == 1) return S.sb; else return 127; }

__device__ __forceinline__ void glds16s(const void* sbase, unsigned voff, unsigned lds_dst) {
    unsigned keep;
    asm volatile("s_mov_b32 %0, m0\n\ts_mov_b32 m0, %3\n\ts_nop 0\n\tglobal_load_lds_dwordx4 %1, %2\n\ts_mov_b32 m0, %0"
                 : "=&s"(keep) : "v"(voff), "s"(sbase), "s"(lds_dst) : "memory");
}
__device__ __forceinline__ const char* uniform_ptr(const char* p) {
    const unsigned long long v = (unsigned long long)p;
    const unsigned lo = __builtin_amdgcn_readfirstlane((unsigned)v), hi = __builtin_amdgcn_readfirstlane((unsigned)(v >> 32));
    return (const char*)(((unsigned long long)hi << 32) | lo);
}

template <class Epi, class Prob>
__device__ __forceinline__ void gemm_phase(LAS unsigned char* lds, const Prob& S, const Epi& E, const int K) {
    int tid_ = threadIdx.x; asm volatile("" : "+v"(tid_));
    const int tid = tid_, wid = __builtin_amdgcn_readfirstlane(tid >> 6), lane = tid & 63, wr = wid >> 2, wc = wid & 3, fr = lane & 15, fq = lane >> 4;
    const int nt = K * Prob::esz / (BK * 2);
    int R[2], C[2]; unsigned voffB[2];
#pragma unroll
    for (int i = 0; i < 2; ++i) { stage_rc(tid * 16 + i * 8192, R[i], C[i]); const int Rb = Epi::PERM ? ((R[i] & ~31) + perm32(R[i] & 31)) : R[i]; voffB[i] = (unsigned)(Rb * S.ldb * Prob::esz + 2 * C[i]); }
    const size_t kstep = (size_t)(BK * 2);
    const int sclA = prob_sa(S), sclB = prob_sb(S); (void)sclA; (void)sclB;
    const size_t hstepB = (size_t)HALF * S.ldb * Prob::esz;
    const unsigned ldsw = (unsigned)wid * 1024u;
    const unsigned ldsbase = __builtin_amdgcn_readfirstlane((unsigned)(size_t)lds);
    const int aoff = lds_byte(wr * 64 + fr, fq * 8), boff = lds_byte(wc * 32 + fr, fq * 8);
#define PG8_SA(b, h) (((b) * 2 + (h)) * HTB)
#define PG8_SB(b, h) ((4 + (b) * 2 + (h)) * HTB)
#define PG8_STAGE(bufoff, gbase, voff) do { _Pragma("unroll") for (int _i = 0; _i < 2; ++_i) glds16s((gbase), (voff)[_i], ldsbase + (unsigned)(bufoff) + ldsw + (unsigned)(_i * 8192)); } while (0)
#define PG8_LDA(dst, b, h) do { if constexpr (Prob::esz == 2) { _Pragma("unroll") for (int m = 0; m < 4; ++m) _Pragma("unroll") for (int k = 0; k < 2; ++k) dst[m][k] = *(const LAS bf16x8*)(lds + PG8_SA(b, h) + aoff + m * 2048 + k * 1024); } \
        else { _Pragma("unroll") for (int m = 0; m < 4; ++m) { const i32x4v lo_ = *(const LAS i32x4v*)(lds + PG8_SA(b, h) + aoff + m * 2048), hi_ = *(const LAS i32x4v*)(lds + PG8_SA(b, h) + aoff + m * 2048 + 1024); dst##8[m] = __builtin_shufflevector(lo_, hi_, 0, 1, 2, 3, 4, 5, 6, 7); } } } while (0)
#define PG8_LDB(dst, b, h) do { if constexpr (Prob::esz == 2) { _Pragma("unroll") for (int n = 0; n < 2; ++n) _Pragma("unroll") for (int k = 0; k < 2; ++k) dst[n][k] = *(const LAS bf16x8*)(lds + PG8_SB(b, h) + boff + n * 2048 + k * 1024); } \
        else { _Pragma("unroll") for (int n = 0; n < 2; ++n) { const i32x4v lo_ = *(const LAS i32x4v*)(lds + PG8_SB(b, h) + boff + n * 2048), hi_ = *(const LAS i32x4v*)(lds + PG8_SB(b, h) + boff + n * 2048 + 1024); dst##8[n] = __builtin_shufflevector(lo_, hi_, 0, 1, 2, 3, 4, 5, 6, 7); } } } while (0)
#define PG8_MMA(ai, bj, At, Bt) do { __builtin_amdgcn_s_setprio(1); _Pragma("unroll") for (int m = 0; m < 4; ++m) _Pragma("unroll") for (int n = 0; n < 2; ++n) { \
        if constexpr (Prob::esz == 2) { _Pragma("unroll") for (int k = 0; k < 2; ++k) acc[ai][bj][m][n] = __builtin_amdgcn_mfma_f32_16x16x32_bf16(Bt[n][k], At[m][k], acc[ai][bj][m][n], 0, 0, 0); } \
        else asm volatile("v_mfma_f32_16x16x128_f8f6f4 %0, %1, %2, %0" : "+v"(acc[ai][bj][m][n]) : "v"(Bt##8[n]), "v"(At##8[m])); } \
        __builtin_amdgcn_s_setprio(0); } while (0)
#define PG8_WAIT_V(n) asm volatile("s_waitcnt vmcnt(" #n ")" ::: "memory")
#define PG8_WAIT_VF() do { if (fresh) asm volatile("s_waitcnt vmcnt(%0)" :: "n"(Epi::NST + 8) : "memory"); else asm volatile("s_waitcnt vmcnt(8)" ::: "memory"); } while (0)
#define PG8_WAIT_L(n) asm volatile("s_waitcnt lgkmcnt(" #n ")" ::: "memory")
#define PG8_BAR __builtin_amdgcn_s_barrier()
#define PG8_SCHED __builtin_amdgcn_sched_barrier(0)
    Unit cur, nxt; int ui = 0;
    if (!S.next(0, cur)) return;
    Acc acc;
#pragma unroll
    for (int a = 0; a < 2; ++a)
#pragma unroll
        for (int b = 0; b < 2; ++b)
#pragma unroll
            for (int m = 0; m < 4; ++m)
#pragma unroll
                for (int n = 0; n < 2; ++n) acc[a][b][m][n] = (f32x4){0.f, 0.f, 0.f, 0.f};
    bf16x8 At[4][2], B0[2][2], B1[2][2];
    i32x8v At8[4], B08[2], B18[2];
    (void)At; (void)B0; (void)B1; (void)At8; (void)B08; (void)B18;
    unsigned offA[2][2], noffA[2][2];
    S.a_off(cur, R, C, offA);
    const char* const Ab = uniform_ptr(S.a_base());
    const char* cB = uniform_ptr(S.b_base(cur));
    PG8_STAGE(PG8_SB(0, 0), cB, voffB); PG8_STAGE(PG8_SB(0, 1), cB + hstepB, voffB); PG8_STAGE(PG8_SA(0, 0), Ab, offA[0]); PG8_STAGE(PG8_SA(0, 1), Ab, offA[1]);
    if (wr == 1) PG8_BAR;
    PG8_WAIT_V(2); PG8_BAR;
    PG8_STAGE(PG8_SB(1, 0), cB + kstep, voffB); PG8_STAGE(PG8_SA(1, 0), Ab + kstep, offA[0]); PG8_STAGE(PG8_SB(1, 1), cB + hstepB + kstep, voffB);
    PG8_WAIT_V(6); PG8_BAR;
    for (;;) {
        const bool has_next = S.next(ui + 1, nxt);
        const char* nB = cB;
        if (has_next) { S.a_off(nxt, R, C, noffA); nB = uniform_ptr(S.b_base(nxt)); }
        else {
#pragma unroll
            for (int h = 0; h < 2; ++h)
#pragma unroll
                for (int i = 0; i < 2; ++i) noffA[h][i] = offA[h][i];
        }
#pragma unroll 1
        for (int t = 0; t < nt; t += 2) {
            const bool last = (t == nt - 2);
            const char* a1 = Ab + (size_t)(t + 1) * kstep;
            const char* a2 = last ? Ab : Ab + (size_t)(t + 2) * kstep; const char* b2 = last ? nB : cB + (size_t)(t + 2) * kstep;
            const char* a3 = a2 + kstep; const char* b3 = b2 + kstep;
            unsigned o2[2][2];
#pragma unroll
            for (int h = 0; h < 2; ++h)
#pragma unroll
                for (int i = 0; i < 2; ++i) o2[h][i] = last ? noffA[h][i] : offA[h][i];
            const bool fresh = (t == 0) && (ui > 0);
            PG8_LDB(B0, 0, 0); PG8_LDB(B1, 0, 1); PG8_SCHED; PG8_LDA(At, 0, 0); if (!fresh) PG8_STAGE(PG8_SA(1, 1), a1, offA[1]);
            PG8_WAIT_VF(); PG8_WAIT_L(0); PG8_BAR; PG8_MMA(0, 0, At, B0); PG8_MMA(0, 1, At, B1); PG8_BAR; PG8_SCHED;
            PG8_LDA(At, 0, 1); PG8_STAGE(PG8_SB(0, 0), b2, voffB); PG8_STAGE(PG8_SB(0, 1), b2 + hstepB, voffB); PG8_STAGE(PG8_SA(0, 0), a2, o2[0]);
            PG8_WAIT_VF(); PG8_WAIT_L(0); PG8_BAR; PG8_MMA(1, 0, At, B0); PG8_MMA(1, 1, At, B1); PG8_BAR; PG8_SCHED;
            PG8_LDB(B0, 1, 0); PG8_LDB(B1, 1, 1); PG8_SCHED; PG8_LDA(At, 1, 0); PG8_STAGE(PG8_SA(0, 1), a2, o2[1]);
            PG8_WAIT_VF(); PG8_WAIT_L(0); PG8_BAR; PG8_MMA(0, 0, At, B0); PG8_MMA(0, 1, At, B1); PG8_BAR; PG8_SCHED;
            PG8_LDA(At, 1, 1); PG8_STAGE(PG8_SB(1, 0), b3, voffB); PG8_STAGE(PG8_SB(1, 1), b3 + hstepB, voffB); PG8_STAGE(PG8_SA(1, 0), a3, o2[0]);
            PG8_WAIT_V(8); PG8_WAIT_L(0); PG8_BAR; PG8_MMA(1, 0, At, B0); PG8_MMA(1, 1, At, B1); PG8_BAR; PG8_SCHED;
        }
        if (has_next) PG8_STAGE(PG8_SA(1, 1), Ab + kstep, noffA[1]);
        if (wr == 0) PG8_BAR;
        if constexpr (Prob::esz == 1) asm volatile("s_nop 15\n\ts_nop 15" ::: "memory");
        E(acc, cur, wr, wc, fr, fq);
        if (!has_next) break;
#pragma unroll
        for (int a = 0; a < 2; ++a)
#pragma unroll
            for (int b = 0; b < 2; ++b)
#pragma unroll
                for (int m = 0; m < 4; ++m)
#pragma unroll
                    for (int n = 0; n < 2; ++n) acc[a][b][m][n] = (f32x4){0.f, 0.f, 0.f, 0.f};
        cur = nxt; cB = nB; ++ui;
#pragma unroll
        for (int h = 0; h < 2; ++h)
#pragma unroll
            for (int i = 0; i < 2; ++i) offA[h][i] = noffA[h][i];
        if (wr == 1) PG8_BAR;
    }
    PG8_WAIT_V(0);
    PG8_BAR;
#undef PG8_SA
#undef PG8_SB
#undef PG8_STAGE
#undef PG8_LDA
#undef PG8_LDB
#undef PG8_MMA
#undef PG8_WAIT_V
#undef PG8_WAIT_VF
#undef PG8_WAIT_L
#undef PG8_BAR
#undef PG8_SCHED
}
}

typedef float f32x16 __attribute__((ext_vector_type(16)));
typedef short s16x4 __attribute__((ext_vector_type(4)));
typedef __bf16 bf16x2_t __attribute__((ext_vector_type(2)));
__device__ __forceinline__ unsigned cvtpk(float lo, float hi) { f32x2_t v = {lo, hi}; bf16x2_t b = __builtin_convertvector(v, bf16x2_t); return __builtin_bit_cast(unsigned, b); }
__device__ __forceinline__ int crow(int i, int h) { return (i & 3) + 8 * (i >> 2) + 4 * h; }
__device__ __forceinline__ bf16x8 pack_step(const f32x16& x, int s) {
    u32x4 w; w.x = cvtpk(x[8 * s + 0], x[8 * s + 1]); w.y = cvtpk(x[8 * s + 2], x[8 * s + 3]); w.z = cvtpk(x[8 * s + 4], x[8 * s + 5]); w.w = cvtpk(x[8 * s + 6], x[8 * s + 7]);
    return __builtin_bit_cast(bf16x8, w);
}
#define MFMA32(a, b, c) __builtin_amdgcn_mfma_f32_32x32x16_bf16((a), (b), (c), 0, 0, 0)

constexpr int SWA_KROW = 144;
constexpr int SWA_VROW = 520;
constexpr int SWA_VOFF = 256 * SWA_KROW;

__device__ __forceinline__ void phase_swa(const P& p, int bid, int nblk, LAS unsigned char* lds) {
    const int tid = otid(), wave = __builtin_amdgcn_readfirstlane(tid >> 6), lane = tid & 63, r = lane & 31, h = lane >> 5;
    const bf16_t* QKV = (const bf16_t*)(p.ws + WS_U);
    unsigned char* Z = p.ws + WS_Z;
    LAS unsigned char* Ks = lds;
    LAS unsigned char* Vs = lds + SWA_VOFF;
    constexpr float LOG2E = 1.4426950408889634f;
    const int upb = (NB * 4 * 32) / nblk;
    u32x4 kst[4], vst[4]; bf16x8 qfn[4];
#define SWA_STAGE_LOAD(ID) do { const int id_ = (ID), n_ = id_ & 31, hk_ = (id_ >> 5) & 3, b_ = id_ >> 7; const int kb0_ = (n_ == 0) ? 0 : (n_ - 1) * 128; \
        _Pragma("unroll") for (int q = 0; q < 4; ++q) { const int pc = tid + q * NT, kv = pc >> 3, c8 = pc & 7; \
            const size_t row = (size_t)b_ * SEQ + (kv < 128 ? kb0_ + kv : n_ * 128 + kv - 128); \
            kst[q] = *(const u32x4*)(QKV + row * 1536 + 1024 + hk_ * 64 + c8 * 8); vst[q] = *(const u32x4*)(QKV + row * 1536 + 1280 + hk_ * 64 + c8 * 8); } } while (0)
#define SWA_Q_LOAD(ID, QT) do { const int id_ = (ID), n_ = id_ & 31, hk_ = (id_ >> 5) & 3, b_ = id_ >> 7; const int a_ = (wave & 1) * 2 + (QT); \
        const size_t qrow_ = (size_t)b_ * SEQ + n_ * 128 + a_ * 32 + r; const int hq_ = hk_ * 4 + (wave >> 1); \
        _Pragma("unroll") for (int s = 0; s < 4; ++s) qfn[s] = *(const bf16x8*)(QKV + qrow_ * 1536 + hq_ * 64 + s * 16 + h * 8); } while (0)
    SWA_STAGE_LOAD(bid * upb); SWA_Q_LOAD(bid * upb, 0);
    for (int ui = 0; ui < upb; ++ui) {
        const int id = bid * upb + ui, n = id & 31, hk = (id >> 5) & 3, b = id >> 7;
#pragma unroll
        for (int q = 0; q < 4; ++q) {
            const int pc = tid + q * NT, kv = pc >> 3, c8 = pc & 7;
            const u32x4 kq = kst[q], vq = vst[q];
            *(LAS u32x4*)(Ks + kv * SWA_KROW + c8 * 16) = kq;
            LAS unsigned char* vp = Vs + (c8 * 8) * SWA_VROW + kv * 2;
            *(LAS unsigned short*)(vp + 0 * SWA_VROW) = (unsigned short)(vq.x & 0xffffu); *(LAS unsigned short*)(vp + 1 * SWA_VROW) = (unsigned short)(vq.x >> 16);
            *(LAS unsigned short*)(vp + 2 * SWA_VROW) = (unsigned short)(vq.y & 0xffffu); *(LAS unsigned short*)(vp + 3 * SWA_VROW) = (unsigned short)(vq.y >> 16);
            *(LAS unsigned short*)(vp + 4 * SWA_VROW) = (unsigned short)(vq.z & 0xffffu); *(LAS unsigned short*)(vp + 5 * SWA_VROW) = (unsigned short)(vq.z >> 16);
            *(LAS unsigned short*)(vp + 6 * SWA_VROW) = (unsigned short)(vq.w & 0xffffu); *(LAS unsigned short*)(vp + 7 * SWA_VROW) = (unsigned short)(vq.w >> 16);
        }
        __syncthreads();
        const int hq = hk * 4 + (wave >> 1);
        const float sink = p.swa_sinks[hq];
#pragma unroll 1
        for (int qt = 0; qt < 2; ++qt) {
            const int a = (wave & 1) * 2 + qt;
            const size_t qrow = (size_t)b * SEQ + n * 128 + a * 32 + r;
            bf16x8 qf[4];
#pragma unroll
            for (int s = 0; s < 4; ++s) qf[s] = qfn[s];
            if (qt == 0) SWA_Q_LOAD(id, 1);
            else if (ui + 1 < upb) { SWA_STAGE_LOAD(id + 1); SWA_Q_LOAD(id + 1, 0); }
            f32x16 st[5];
#pragma unroll
            for (int dl = 0; dl < 5; ++dl) {
#pragma unroll
                for (int i = 0; i < 16; ++i) st[dl][i] = 0.f;
                const LAS unsigned char* kp = Ks + ((a + dl) * 32 + r) * SWA_KROW + h * 16;
#pragma unroll
                for (int s = 0; s < 4; ++s) { const bf16x8 kf = *(const LAS bf16x8*)(kp + s * 32); st[dl] = MFMA32(kf, qf[s], st[dl]); }
            }
#pragma unroll
            for (int i = 0; i < 16; ++i) { const int c = crow(i, h); if (!(c > r)) st[0][i] = -INFINITY; if (!(c <= r)) st[4][i] = -INFINITY; }
            if (n == 0) {
#pragma unroll
                for (int dl = 0; dl < 5; ++dl) if (a + dl < 4) {
#pragma unroll
                    for (int i = 0; i < 16; ++i) st[dl][i] = -INFINITY; }
            }
            float m = sink;
#pragma unroll
            for (int dl = 0; dl < 5; ++dl)
#pragma unroll
                for (int i = 0; i < 16; ++i) m = fmaxf(m, st[dl][i]);
            m = fmaxf(m, __shfl_xor(m, 32));
            const float mb = m * LOG2E;
            float l = 0.f;
#pragma unroll
            for (int dl = 0; dl < 5; ++dl)
#pragma unroll
                for (int i = 0; i < 16; ++i) { const float e = __builtin_amdgcn_exp2f(st[dl][i] * LOG2E - mb); st[dl][i] = e; l += e; }
            l += __shfl_xor(l, 32);
            l += __builtin_amdgcn_exp2f(sink * LOG2E - mb);
            f32x16 o[2];
#pragma unroll
            for (int dt = 0; dt < 2; ++dt)
#pragma unroll
                for (int i = 0; i < 16; ++i) o[dt][i] = 0.f;
#pragma unroll
            for (int dl = 0; dl < 5; ++dl)
#pragma unroll
                for (int s = 0; s < 2; ++s) {
                    const bf16x8 pf = pack_step(st[dl], s);
#pragma unroll
                    for (int dt = 0; dt < 2; ++dt) {
                        const LAS unsigned char* vp = Vs + (32 * dt + r) * SWA_VROW + ((a + dl) * 32 + 16 * s + 4 * h) * 2;
                        const s16x4 lo = *(const LAS s16x4*)vp, hi = *(const LAS s16x4*)(vp + 16);
                        const bf16x8 vf = __builtin_shufflevector(lo, hi, 0, 1, 2, 3, 4, 5, 6, 7);
                        o[dt] = MFMA32(vf, pf, o[dt]);
                    }
                }
            const float inv = 8.f / l;
            unsigned char* zp = Z + qrow * D + hq * 64 + 4 * h;
#pragma unroll
            for (int dt = 0; dt < 2; ++dt)
#pragma unroll
                for (int g = 0; g < 4; ++g) *(unsigned*)(zp + 32 * dt + 8 * g) = pk8x4(o[dt][4 * g] * inv, o[dt][4 * g + 1] * inv, o[dt][4 * g + 2] * inv, o[dt][4 * g + 3] * inv);
        }
        __syncthreads();
    }
#undef SWA_STAGE_LOAD
#undef SWA_Q_LOAD
}

constexpr int HG_QT = 0, HG_KT = 17408, HG_KTT = 34816, HG_VT = 53248, HG_TOT = 57856, HG_VEC = 61952, HG_PO = 63488, HG_POA = 96256;
constexpr int HG_P = 272, HG_PT = 144;
#define HG_LBAR() do { asm volatile("s_waitcnt lgkmcnt(0)" ::: "memory"); __builtin_amdgcn_s_barrier(); asm volatile("" ::: "memory"); } while (0)

__device__ __forceinline__ void phase_hgrn(const P& p, int bid, int nblk, LAS unsigned char* lds) {
    const int tid = otid(), wave = __builtin_amdgcn_readfirstlane(tid >> 6), lane = tid & 63, r = lane & 31, h = lane >> 5;
    const bf16_t* U1 = (const bf16_t*)(p.ws + WS_U);
    bf16_t* O = (bf16_t*)(p.ws + WS_O);
    for (int unit = bid; unit < NB * 8 * 4; unit += nblk) {
        const int vs = unit & 3, hh = (unit >> 2) & 7, b = unit >> 5;
        f32x16 S;
#pragma unroll
        for (int i = 0; i < 16; ++i) S[i] = 0.f;
        const bf16_t* qbase = U1 + ((size_t)b * SEQ + wave * 8) * 4096 + hh * 128 + 2 * lane;
        const bf16_t* vbase = U1 + ((size_t)b * SEQ + (tid >> 3)) * 4096 + 2048 + hh * 128 + vs * 32 + (tid & 7) * 4;
        unsigned qraw[8], kraw[8], qnx[8], knx[8]; u32x2 vraw, vnx;
#pragma unroll
        for (int i = 0; i < 8; ++i) { qraw[i] = *(const unsigned*)(qbase + (size_t)i * 4096); kraw[i] = *(const unsigned*)(qbase + (size_t)i * 4096 + 1024); }
        vraw = *(const u32x2*)vbase;
        asm volatile("" :: "v"(qraw[0]), "v"(qraw[1]), "v"(qraw[2]), "v"(qraw[3]), "v"(qraw[4]), "v"(qraw[5]), "v"(qraw[6]), "v"(qraw[7]), "v"(kraw[0]), "v"(kraw[1]), "v"(kraw[2]), "v"(kraw[3]), "v"(kraw[4]), "v"(kraw[5]), "v"(kraw[6]), "v"(kraw[7]), "v"(vraw));
#pragma unroll 1
        for (int c = 0; c < SEQ / 64; ++c) {
            {
                const int cn = (c + 1 < SEQ / 64) ? c + 1 : SEQ / 64 - 1;
                const size_t adv = (size_t)cn * 64 * 4096;
#pragma unroll
                for (int i = 0; i < 8; ++i) { qnx[i] = *(const unsigned*)(qbase + adv + (size_t)i * 4096); knx[i] = *(const unsigned*)(qbase + adv + (size_t)i * 4096 + 1024); }
                vnx = *(const u32x2*)(vbase + adv);
                asm volatile("" ::: "memory");
            }
            float q0[8], q1[8], k0[8], k1[8], c0[8], c1[8];
            float a0 = 1.f, a1 = 1.f;
#pragma unroll
            for (int i = 0; i < 8; ++i) { q0[i] = bflo(qraw[i]); q1[i] = bfhi(qraw[i]); k0[i] = bflo(kraw[i]); k1[i] = bfhi(kraw[i]);
                a0 *= 1.f - k0[i]; a1 *= 1.f - k1[i]; c0[i] = a0; c1[i] = a1; }
            { f32x2_t tv = {a0, a1}; *(LAS f32x2_t*)(lds + HG_TOT + (wave * 128 + 2 * lane) * 4) = tv; }
            const u32x2 vcur = vraw;
            HG_LBAR();
            float lo0 = 1.f, lo1 = 1.f, hi0 = 1.f, hi1 = 1.f, em0 = 1.f, em1 = 1.f, el0 = 1.f, el1 = 1.f;
#pragma unroll
            for (int w2 = 0; w2 < 8; ++w2) { const f32x2_t tv = *(const LAS f32x2_t*)(lds + HG_TOT + (w2 * 128 + 2 * lane) * 4);
                if (w2 < 4) { em0 *= tv.x; em1 *= tv.y; if (w2 >= wave) { lo0 *= tv.x; lo1 *= tv.y; } }
                else { el0 *= tv.x; el1 *= tv.y; if (w2 < wave) { hi0 *= tv.x; hi1 *= tv.y; } } }
            const float sc0 = (wave >= 4) ? hi0 : __builtin_amdgcn_rcpf(lo0), sc1 = (wave >= 4) ? hi1 : __builtin_amdgcn_rcpf(lo1);
            u32x4 kt0, kt1;
            unsigned ktw0[4], ktw1[4];
#pragma unroll
            for (int i = 0; i < 8; i += 2) {
                const float e00 = c0[i] * sc0, e01 = c1[i] * sc1, e10 = c0[i + 1] * sc0, e11 = c1[i + 1] * sc1;
                const float r00 = __builtin_amdgcn_rcpf(e00), r01 = __builtin_amdgcn_rcpf(e01), r10 = __builtin_amdgcn_rcpf(e10), r11 = __builtin_amdgcn_rcpf(e11);
                const float kk00 = k0[i] * r00, kk01 = k1[i] * r01, kk10 = k0[i + 1] * r10, kk11 = k1[i + 1] * r11;
                const int t = wave * 8 + i;
                *(LAS unsigned*)(lds + HG_QT + t * HG_P + lane * 4) = cvtpk(q0[i] * e00, q1[i] * e01);
                *(LAS unsigned*)(lds + HG_QT + (t + 1) * HG_P + lane * 4) = cvtpk(q0[i + 1] * e10, q1[i + 1] * e11);
                *(LAS unsigned*)(lds + HG_KT + t * HG_P + lane * 4) = cvtpk(kk00, kk01);
                *(LAS unsigned*)(lds + HG_KT + (t + 1) * HG_P + lane * 4) = cvtpk(kk10, kk11);
                ktw0[i >> 1] = cvtpk(kk00, kk10); ktw1[i >> 1] = cvtpk(kk01, kk11);
            }
            kt0.x = ktw0[0]; kt0.y = ktw0[1]; kt0.z = ktw0[2]; kt0.w = ktw0[3]; kt1.x = ktw1[0]; kt1.y = ktw1[1]; kt1.z = ktw1[2]; kt1.w = ktw1[3];
            *(LAS u32x4*)(lds + HG_KTT + (2 * lane) * HG_PT + wave * 16) = kt0;
            *(LAS u32x4*)(lds + HG_KTT + (2 * lane + 1) * HG_PT + wave * 16) = kt1;
            if (wave == 0) {
                f32x2_t em = {em0, em1}, el = {el0, el1}, gg = {em0 * el0, em1 * el1};
                *(LAS f32x2_t*)(lds + HG_VEC + (2 * lane) * 4) = em; *(LAS f32x2_t*)(lds + HG_VEC + 512 + (2 * lane) * 4) = el; *(LAS f32x2_t*)(lds + HG_VEC + 1024 + (2 * lane) * 4) = gg;
            }
            { const int s = tid >> 3, j4 = (tid & 7) * 4; LAS unsigned char* vp = lds + HG_VT + j4 * HG_PT + s * 2;
                *(LAS unsigned short*)(vp) = (unsigned short)(vcur.x & 0xffffu); *(LAS unsigned short*)(vp + HG_PT) = (unsigned short)(vcur.x >> 16);
                *(LAS unsigned short*)(vp + 2 * HG_PT) = (unsigned short)(vcur.y & 0xffffu); *(LAS unsigned short*)(vp + 3 * HG_PT) = (unsigned short)(vcur.y >> 16); }
            HG_LBAR();
            if (wave < 4) {
                const int w = wave;
                f32x4 emv[4], elv[4], gv[4];
#pragma unroll
                for (int g4 = 0; g4 < 4; ++g4) { const int d = 32 * w + 8 * g4 + 4 * h;
                    emv[g4] = *(const LAS f32x4*)(lds + HG_VEC + d * 4); elv[g4] = *(const LAS f32x4*)(lds + HG_VEC + 512 + d * 4); gv[g4] = *(const LAS f32x4*)(lds + HG_VEC + 1024 + d * 4); }
                f32x16 Sem;
#pragma unroll
                for (int i = 0; i < 16; ++i) Sem[i] = S[i] * emv[i >> 2][i & 3];
                const bf16x8 bS0 = pack_step(Sem, 0), bS1 = pack_step(Sem, 1);
#pragma unroll
                for (int tt = 0; tt < 2; ++tt) {
                    f32x16 op;
#pragma unroll
                    for (int i = 0; i < 16; ++i) op[i] = 0.f;
#pragma unroll
                    for (int sp = 0; sp < 2; ++sp) {
                        const LAS unsigned char* ap = lds + HG_QT + (32 * tt + r) * HG_P + (32 * w + 16 * sp + 4 * h) * 2;
                        const s16x4 lo = *(const LAS s16x4*)ap, hi = *(const LAS s16x4*)(ap + 16);
                        const bf16x8 aq = __builtin_shufflevector(lo, hi, 0, 1, 2, 3, 4, 5, 6, 7);
                        op = MFMA32(aq, sp == 0 ? bS0 : bS1, op);
                    }
#pragma unroll
                    for (int g4 = 0; g4 < 4; ++g4) { f32x4 v = {op[4 * g4], op[4 * g4 + 1], op[4 * g4 + 2], op[4 * g4 + 3]};
                        *(LAS f32x4*)(lds + HG_PO + ((w * 2 + tt) * 4 + g4) * 1024 + lane * 16) = v; }
                }
                f32x16 dS;
#pragma unroll
                for (int i = 0; i < 16; ++i) dS[i] = 0.f;
#pragma unroll
                for (int ks = 0; ks < 4; ++ks) {
                    const bf16x8 ak = *(const LAS bf16x8*)(lds + HG_KTT + (32 * w + r) * HG_PT + (16 * ks + 8 * h) * 2);
                    const bf16x8 bv = *(const LAS bf16x8*)(lds + HG_VT + r * HG_PT + (16 * ks + 8 * h) * 2);
                    dS = MFMA32(ak, bv, dS);
                }
#pragma unroll
                for (int i = 0; i < 16; ++i) S[i] = S[i] * gv[i >> 2][i & 3] + dS[i] * elv[i >> 2][i & 3];
            } else if (wave < 7) {
                const int ss = (wave == 6) ? 1 : 0, tt = (wave == 4) ? 0 : 1;
                f32x16 at;
#pragma unroll
                for (int i = 0; i < 16; ++i) at[i] = 0.f;
#pragma unroll
                for (int kd = 0; kd < 8; ++kd) {
                    const bf16x8 ak = *(const LAS bf16x8*)(lds + HG_KT + (32 * ss + r) * HG_P + (16 * kd + 8 * h) * 2);
                    const bf16x8 bq = *(const LAS bf16x8*)(lds + HG_QT + (32 * tt + r) * HG_P + (16 * kd + 8 * h) * 2);
                    at = MFMA32(ak, bq, at);
                }
                if (ss == tt) {
#pragma unroll
                    for (int i = 0; i < 16; ++i) if (crow(i, h) > r) at[i] = 0.f;
                }
                f32x16 oi;
#pragma unroll
                for (int i = 0; i < 16; ++i) oi[i] = 0.f;
#pragma unroll
                for (int sp = 0; sp < 2; ++sp) {
                    const bf16x8 pa = pack_step(at, sp);
                    const LAS unsigned char* vp = lds + HG_VT + r * HG_PT + (32 * ss + 16 * sp + 4 * h) * 2;
                    const s16x4 lo = *(const LAS s16x4*)vp, hi = *(const LAS s16x4*)(vp + 16);
                    const bf16x8 vb = __builtin_shufflevector(lo, hi, 0, 1, 2, 3, 4, 5, 6, 7);
                    oi = MFMA32(pa, vb, oi);
                }
#pragma unroll
                for (int g4 = 0; g4 < 4; ++g4) { f32x4 v = {oi[4 * g4], oi[4 * g4 + 1], oi[4 * g4 + 2], oi[4 * g4 + 3]};
                    *(LAS f32x4*)(lds + HG_POA + ((wave - 4) * 4 + g4) * 1024 + lane * 16) = v; }
            }
            HG_LBAR();
            {
                const int tt = wave >> 2, g4 = wave & 3;
                f32x4 sum = *(const LAS f32x4*)(lds + HG_PO + ((0 * 2 + tt) * 4 + g4) * 1024 + lane * 16);
#pragma unroll
                for (int w2 = 1; w2 < 4; ++w2) sum += *(const LAS f32x4*)(lds + HG_PO + ((w2 * 2 + tt) * 4 + g4) * 1024 + lane * 16);
                if (tt == 0) sum += *(const LAS f32x4*)(lds + HG_POA + (0 * 4 + g4) * 1024 + lane * 16);
                else { sum += *(const LAS f32x4*)(lds + HG_POA + (1 * 4 + g4) * 1024 + lane * 16); sum += *(const LAS f32x4*)(lds + HG_POA + (2 * 4 + g4) * 1024 + lane * 16); }
                bf16_t* op_ = O + ((size_t)b * SEQ + c * 64 + 32 * tt + 8 * g4 + 4 * h) * D + hh * 128 + vs * 32 + r;
#pragma unroll
                for (int e = 0; e < 4; ++e) op_[(size_t)e * D] = (bf16_t)f2bf(sum[e]);
            }
            asm volatile("" ::: "memory");
#pragma unroll
            for (int i = 0; i < 8; ++i) { qraw[i] = qnx[i]; kraw[i] = knx[i]; }
            vraw = vnx;
            asm volatile("" :: "v"(qraw[0]), "v"(qraw[1]), "v"(qraw[2]), "v"(qraw[3]), "v"(qraw[4]), "v"(qraw[5]), "v"(qraw[6]), "v"(qraw[7]), "v"(kraw[0]), "v"(kraw[1]), "v"(kraw[2]), "v"(kraw[3]), "v"(kraw[4]), "v"(kraw[5]), "v"(kraw[6]), "v"(kraw[7]), "v"(vraw));
        }
        __syncthreads();
    }
}

#define XB_TMO      128
#define XB_XCNT(j)  (256  + 64 * (j))
#define XB_XSUB(j)  (1280 + 64 * (j))
#define XB_XGEN(j)  (2304 + 64 * (j))
#define XB_TOP      3328
#define XB_TOPGEN   3392
#define XCD_BAR_WORDS 3456
#define XB_SPIN_CAP (1u << 18)

__device__ __forceinline__ unsigned xb_ld(unsigned* p)              { return __hip_atomic_load(p, __ATOMIC_RELAXED, __HIP_MEMORY_SCOPE_AGENT); }
__device__ __forceinline__ unsigned xb_add(unsigned* p, unsigned v) { return __hip_atomic_fetch_add(p, v, __ATOMIC_RELAXED, __HIP_MEMORY_SCOPE_AGENT); }
__device__ __forceinline__ unsigned xb_xcc_id() { return (unsigned)__builtin_amdgcn_s_getreg((3 << 11) | 20) & 0xFu; }
#define XB_SPIN(cond, bar) do { unsigned _sp = 0; while (cond) { __builtin_amdgcn_s_sleep(1); \
    if ((++_sp & 255u) == 0u) { if (xb_ld(&(bar)[XB_TMO])) break; if (_sp > XB_SPIN_CAP) { atomicAdd(&(bar)[XB_TMO], 1u); break; } } } } while (0)

struct XcdBarrier {
    unsigned* bar; unsigned x;
    volatile LAS unsigned* st;
};
__device__ __forceinline__ XcdBarrier xcd_barrier_post(unsigned* bar, volatile LAS unsigned* st) {
    XcdBarrier b; b.bar = bar; b.x = xb_xcc_id(); b.st = st;
    if (threadIdx.x == 0) (void)xb_add(&bar[XB_XCNT(b.x)], 1u);
    return b;
}
__device__ __forceinline__ void xcd_barrier_complete(unsigned* bar, unsigned x, unsigned& nloc, unsigned& nx) {
    const unsigned G = gridDim.x * gridDim.y * gridDim.z;
    unsigned sum, cnt, mine, sp = 0u;
    for (;;) {
        sum = 0u; cnt = 0u; mine = 0u;
#pragma unroll
        for (unsigned j = 0; j < 16; ++j) { const unsigned c = xb_ld(&bar[XB_XCNT(j)]); sum += c; cnt += (c > 0u) ? 1u : 0u; mine = (j == x) ? c : mine; }
        if (sum == G) break;
        __builtin_amdgcn_s_sleep(1);
        if ((++sp & 255u) == 0u) { if (xb_ld(&bar[XB_TMO])) break; if (sp > XB_SPIN_CAP) { atomicAdd(&bar[XB_TMO], 1u); break; } }
    }
    nloc = mine > 0u ? mine : 1u; nx = cnt > 0u ? cnt : 1u;
}
__device__ __forceinline__ void xcd_barrier(const XcdBarrier& b) {
    asm volatile("s_waitcnt vmcnt(0)" ::: "memory");
    __syncthreads();
    if (threadIdx.x == 0) {
        unsigned* bar = b.bar;
        __builtin_amdgcn_s_waitcnt(0);
        unsigned nloc = b.st[0], nx = b.st[1];
        if (nloc == 0u) { xcd_barrier_complete(bar, b.x, nloc, nx); b.st[0] = nloc; b.st[1] = nx; }
        const unsigned old = xb_add(&bar[XB_XSUB(b.x)], 1u);
        const unsigned gen = old / nloc;
        if (old + 1u == (gen + 1u) * nloc) {
            __builtin_amdgcn_fence(__ATOMIC_RELEASE, "agent");
            asm volatile("s_waitcnt vmcnt(0)" ::: "memory");
            const unsigned og = xb_add(&bar[XB_TOP], 1u);
            const unsigned tg = og / nx;
            if (og + 1u == (tg + 1u) * nx) xb_add(&bar[XB_TOPGEN], 1u);
            else XB_SPIN(xb_ld(&bar[XB_TOPGEN]) == tg, bar);
            __builtin_amdgcn_fence(__ATOMIC_ACQUIRE, "agent");
            xb_add(&bar[XB_XGEN(b.x)], 1u);
            asm volatile("s_waitcnt vmcnt(0)" ::: "memory");
        } else {
            XB_SPIN(xb_ld(&bar[XB_XGEN(b.x)]) == gen, bar);
            __builtin_amdgcn_fence(__ATOMIC_ACQUIRE, "agent");
            asm volatile("s_waitcnt vmcnt(0)" ::: "memory");
        }
    }
    __syncthreads();
}

__device__ __forceinline__ void cvt_item(const float* W, int ldw, int k0, int n0, bf16_t* WT, int ldt, int drow0, LAS unsigned char* T, int lane) {
    const int kp = lane >> 5, nq = lane & 31;
    const float* src = W + (size_t)(k0 + 2 * kp) * ldw + n0 + 4 * nq;
    const unsigned sw = (unsigned)(nq & 28);
#pragma unroll
    for (int half = 0; half < 2; ++half) {
        f32x4 v[8][2];
#pragma unroll
        for (int s = 0; s < 8; ++s) { const float* q = src + (size_t)(4 * (half * 8 + s)) * ldw; v[s][0] = *(const f32x4*)q; v[s][1] = *(const f32x4*)(q + ldw); }
#pragma unroll
        for (int s = 0; s < 8; ++s) {
            const unsigned pd = (unsigned)(2 * (half * 8 + s) + kp);
            const unsigned col = ((pd ^ sw) << 2);
#pragma unroll
            for (int i = 0; i < 4; ++i) *(LAS unsigned*)(T + (4 * nq + i) * 128 + col) = pk2(v[s][0][i], v[s][1][i]);
        }
    }
    asm volatile("s_waitcnt lgkmcnt(0)" ::: "memory");
    const int c = lane & 7;
#pragma unroll 4
    for (int q = 0; q < 16; ++q) {
        const int n = 8 * q + (lane >> 3);
        const u32x4 o = *(const LAS u32x4*)(T + n * 128 + (((unsigned)(4 * c) ^ (unsigned)((n >> 2) & 28)) << 2));
        *(u32x4*)(WT + (size_t)(drow0 + n) * ldt + k0 + 8 * c) = o;
    }
    asm volatile("s_waitcnt lgkmcnt(0)" ::: "memory");
}
__device__ __forceinline__ int dual_row(int n, int half) { return (n >> 7) * 256 + half * 128 + (n & 127); }

__device__ __forceinline__ unsigned pk_fp8x4_(float a, float b, float c, float d) { return pk8x4(a, b, c, d); }
struct CvtSrc { const float* W; unsigned char* WT; int ldw, k0, n0, drow0; };
__device__ __forceinline__ void cvt8_issue(const CvtSrc& s, int qt, int lane, f32x4 (&v)[4][4]) {
    const int kp = lane >> 5, nq = lane & 31;
    const float* ub = s.W + (size_t)(s.k0 + 32 * qt) * s.ldw + s.n0;
    const unsigned lo = (unsigned)(4 * kp * s.ldw + 4 * nq);
#pragma unroll
    for (int st = 0; st < 4; ++st)
#pragma unroll
        for (int rr = 0; rr < 4; ++rr) v[st][rr] = __builtin_nontemporal_load((const f32x4*)(ub + (size_t)(8 * st + rr) * s.ldw + lo));
}
__device__ __forceinline__ void cvt8_pack(int qt, int lane, const f32x4 (&v)[4][4], LAS unsigned char* T, float scale) {
    const int kp = lane >> 5, nq = lane & 31;
    const unsigned sw = (unsigned)(nq & 28);
#pragma unroll
    for (int st = 0; st < 4; ++st) {
        const unsigned pd = (unsigned)(2 * (qt * 4 + st) + kp);
        const unsigned col = ((pd ^ sw) << 2);
#pragma unroll
        for (int i = 0; i < 4; ++i) *(LAS unsigned*)(T + (4 * nq + i) * 128 + col) = pk_fp8x4_(v[st][0][i] * scale, v[st][1][i] * scale, v[st][2][i] * scale, v[st][3][i] * scale);
    }
}
__device__ __forceinline__ void cvt8_flush(const CvtSrc& s, int lane, LAS unsigned char* T) {
    asm volatile("s_waitcnt lgkmcnt(0)" ::: "memory");
    const int c = lane & 7;
#pragma unroll 4
    for (int q = 0; q < 16; ++q) {
        const int n = 8 * q + (lane >> 3);
        const u32x4 o = *(const LAS u32x4*)(T + n * 128 + (((unsigned)(4 * c) ^ (unsigned)((n >> 2) & 28)) << 2));
        *(u32x4*)(s.WT + (size_t)(s.drow0 + n) * 1024 + s.k0 + 16 * c) = o;
    }
    asm volatile("s_waitcnt lgkmcnt(0)" ::: "memory");
}

constexpr int CVPRO = 1;
constexpr int CV_LAYER_ITEMS = 3 * 16 * 64;
constexpr float W8_SCALE = 32.f;
__device__ __forceinline__ CvtSrc moe_item(const P& p, int layer, int it) {
    const int tsr = it >> 10, r = it & 1023, le = layer * NE + (r >> 6), item = r & 63, kb = item >> 3, nb = item & 7;
    CvtSrc s; s.ldw = 1024; s.k0 = kb * 128; s.n0 = nb * 128;
    if (tsr == 0)      { s.W = p.moe_w_gate + (size_t)le * D * FF; s.WT = p.ws + WT_GU + (size_t)le * 2048 * 1024; s.drow0 = dual_row(nb * 128, 0); }
    else if (tsr == 1) { s.W = p.moe_w_up + (size_t)le * D * FF;   s.WT = p.ws + WT_GU + (size_t)le * 2048 * 1024; s.drow0 = dual_row(nb * 128, 1); }
    else               { s.W = p.moe_w_down + (size_t)le * FF * D; s.WT = p.ws + WT_DN + (size_t)le * 1024 * 1024; s.drow0 = nb * 128; }
    return s;
}
constexpr int CV_DENSE8_ITEMS = 64 + 256 + 96 + 192 + 3 * 64;
__device__ __forceinline__ CvtSrc dense8_item(const P& p, int r) {
    CvtSrc s;
    if (r < 64) { const int kb = r >> 3, nb = r & 7; s.W = p.pool_w_in; s.WT = p.ws + WT_POOL_IN; s.ldw = 1024; s.k0 = kb * 128; s.n0 = nb * 128; s.drow0 = nb * 128; return s; } r -= 64;
    if (r < 256) { const int kb = r >> 5, nb = r & 31; s.W = p.hgrn_w_in; s.WT = p.ws + WT_HGRN_IN; s.ldw = 4096; s.k0 = kb * 128; s.n0 = nb * 128; s.drow0 = nb * 128; return s; } r -= 256;
    if (r < 96) { const int kb = r / 12, nb = r % 12; s.W = p.swa_w_in; s.WT = p.ws + WT_SWA_IN; s.ldw = 1536; s.k0 = kb * 128; s.n0 = nb * 128; s.drow0 = nb * 128; return s; } r -= 96;
    if (r >= 192) { r -= 192; const int w = r >> 6, kb = (r >> 3) & 7, nb = r & 7; s.W = w == 0 ? p.hgrn_w_out : (w == 1 ? p.swa_w_out : p.conv_w_out);
        s.WT = p.ws + (w == 0 ? WT_HGRN_OUT : (w == 1 ? WT_SWA_OUT : WT_CONV_OUT)); s.ldw = 1024; s.k0 = kb * 128; s.n0 = nb * 128; s.drow0 = nb * 128; return s; }
    { const int kb = r / 24, nb = r % 24, n0 = nb * 128; s.W = p.conv_w_in; s.WT = p.ws + WT_CONV_IN; s.ldw = 3072; s.k0 = kb * 128; s.n0 = n0;
      s.drow0 = n0 < 1024 ? n0 : (n0 < 2048 ? 1024 + dual_row(n0 - 1024, 0) : 1024 + dual_row(n0 - 2048, 1)); return s; }
}
__device__ __forceinline__ CvtSrc any8_item(const P& p, int layer, int it) { return it < CV_LAYER_ITEMS ? moe_item(p, layer, it) : dense8_item(p, it - CV_LAYER_ITEMS); }
__device__ __forceinline__ void convert_moe(const P& p, int layer, int i0, int i1, int vw, int nvw, LAS unsigned char* T, int lane) {
    int it = __builtin_amdgcn_readfirstlane(i0 + vw);
    if (it >= i1) return;
    f32x4 va[4][4], vb[4][4];
    CvtSrc cur = any8_item(p, layer, it);
    cvt8_issue(cur, 0, lane, va); cvt8_issue(cur, 1, lane, vb);
    for (;;) {
        cvt8_pack(0, lane, va, T, W8_SCALE); cvt8_issue(cur, 2, lane, va);
        cvt8_pack(1, lane, vb, T, W8_SCALE); cvt8_issue(cur, 3, lane, vb);
        const int nx = it + nvw; const bool more = nx < i1;
        const CvtSrc nxt = any8_item(p, layer, more ? nx : it);
        cvt8_pack(2, lane, va, T, W8_SCALE); if (more) cvt8_issue(nxt, 0, lane, va);
        cvt8_pack(3, lane, vb, T, W8_SCALE); if (more) cvt8_issue(nxt, 1, lane, vb);
        cvt8_flush(cur, lane, T);
        if (!more) break;
        cur = nxt; it = nx;
    }
}

__device__ __forceinline__ void phase_convert(const P& p, int bid, int nblk, LAS unsigned char* lds) {
    const int tid = otid(), wave = tid >> 6, lane = tid & 63;
    LAS unsigned char* T = lds + wave * 16384;
    const int gw = bid * NWV + wave, NGW = nblk * NWV;
    unsigned char* ws = p.ws;
    for (int ly = 0; ly < CVPRO; ++ly) convert_moe(p, ly, 0, CV_LAYER_ITEMS + (ly == 0 ? CV_DENSE8_ITEMS : 0), gw, NGW, T, lane);
    constexpr int I_SQ = 128, I_GRP = 32;
    constexpr int NSMALL = I_SQ + I_GRP;
    for (int it = (gw + NGW - (CV_LAYER_ITEMS + CV_DENSE8_ITEMS) % NGW) % NGW; it < NSMALL; it += NGW) {
        int r = it;
        if (r < I_GRP) {
#pragma unroll 4
            for (int q = 0; q < 32; ++q) { const int e4 = r * 2048 + q * 64 + lane, e = e4 * 4, g = e >> 16, d = e & 255; const f32x4 w = *(const f32x4*)(p.pool_w_grp + e) * *(const f32x4*)(p.pool_scale + g * 256 + d);
                u32x2 o; o.x = pk2(w.x, w.y); o.y = pk2(w.z, w.w); *(u32x2*)((bf16_t*)(ws + WT_POOL_GRP) + e) = o; }
            continue; } r -= I_GRP;
        if (r < I_SQ) { cvt_item(p.pool_w_out, D, (r >> 3) * 64, (r & 7) * 128, (bf16_t*)(ws + WT_POOL_OUT), D, (r & 7) * 128, T, lane); continue; } r -= I_SQ;
    }
}

constexpr int LDS_RING = pg8::STAGE_BYTES;
constexpr int LDS_MISC = LDS_RING;
constexpr int LDS_ROWTAB = LDS_RING + 1024;
constexpr int LDS_BYTES = LDS_ROWTAB + 12 * 1024;
constexpr int NPHASE = 31;
constexpr int CV1 = 40, CV2 = 40, CVSPLIT = 2048;

__global__ void __launch_bounds__(NT, 2) mega(P p, int lo, int hi) {
    extern __shared__ __attribute__((aligned(16))) unsigned char lds_raw[];
    LAS unsigned char* lds = (LAS unsigned char*)lds_raw;
    float* ldsf = (float*)lds_raw;
    const int tid = threadIdx.x, bid = blockIdx.x, nblk = gridDim.x;
    unsigned char* ws = p.ws;
    unsigned* ctl = (unsigned*)(ws + WS_CTL);
    const float* mod = (const float*)(ws + WS_MOD);
    const unsigned char* H8 = ws + WS_H; bf16_t* H = (bf16_t*)(ws + WS_H); bf16_t* Z = (bf16_t*)(ws + WS_Z); bf16_t* U = (bf16_t*)(ws + WS_U);
    bf16_t* U2 = (bf16_t*)(ws + WS_U + ((size_t)64 << 20));
    bf16_t* ACT = (bf16_t*)(ws + WS_ACT); bf16_t* Y = (bf16_t*)(ws + WS_Y);
    LAS int* geo = (LAS int*)(lds + LDS_MISC + 16);
    if (tid < 4) ((LAS unsigned*)(lds + LDS_MISC))[tid] = 0u;
    __syncthreads();
    XcdBarrier bar; bar.bar = ctl; bar.x = 0; bar.st = nullptr;
    if (hi - lo > 1) bar = xcd_barrier_post(ctl, (volatile LAS unsigned*)(lds + LDS_MISC));
    int ph = 0;
#define XOUT ((bf16_t*)(ws + WS_XB))
#define CNTL l
#define PH_BEGIN if (lo <= ph && ph < hi) {
#define PH_END if (ph + 1 < hi) xcd_barrier(bar); else __syncthreads(); } ++ph;

    PH_BEGIN  phase_prep(p, bid, nblk, ldsf); __syncthreads(); phase_convert(p, bid, nblk, lds);  PH_END

    for (int l = 0; l < DEPTH; ++l) {
        PH_BEGIN  if (l == 0) { phase_norm<0>(p, l, bid, nblk, ldsf);
                pg8::DenseProb S{(const bf16_t*)(ws + WT_POOL_OUT), (const bf16_t*)(ws + WT_POOL_GRP), D, 256, 256, 4, 4, nblk, bid}; pg8::EpPlain E{(bf16_t*)(ws + WT_POOL_W2), nullptr, D, 1.f, 0, 1.f}; pg8::gemm_phase(lds, S, E, 256); }
            else phase_norm<1>(p, l, bid, nblk, ldsf, -1, XOUT);  PH_END
        const bf16_t* wout; const bf16_t* aout = Z;
        if (l == 0) {
            PH_BEGIN  { pg8::DenseProb8 S{H8, ws + WT_POOL_IN, D, D, M / 256, 4, nblk, bid, 127, 122}; pg8::EpPlain E{U, nullptr, D, 1.f, 0, 0.03125f}; pg8::gemm_phase(lds, S, E, D); }  PH_END
            PH_BEGIN  phase_pool(p, bid, nblk);  PH_END
            wout = (const bf16_t*)(ws + WT_POOL_W2); aout = U2;
        } else if (l == 1) {
            PH_BEGIN  { pg8::DenseProb8 S{H8, ws + WT_HGRN_IN, D, D, M / 256, 16, nblk, bid, 127, 122}; pg8::EpHgrnIn E{U, (const float*)(ws + WS_LB)}; pg8::gemm_phase(lds, S, E, D); }  PH_END
            PH_BEGIN  phase_hgrn(p, bid, nblk, lds);  PH_END
            PH_BEGIN  phase_hgrn_gate(p, bid, nblk);  PH_END
            wout = (const bf16_t*)(ws + WT_HGRN_OUT);
        } else if (l == 2) {
            PH_BEGIN  { pg8::DenseProb8 S{H8, ws + WT_SWA_IN, D, D, M / 256, 6, nblk, bid, 127, 122}; pg8::EpPlain E{U, nullptr, 1536, 0.125f * 0.03125f, 4, 0.03125f}; pg8::gemm_phase(lds, S, E, D); }  PH_END
            PH_BEGIN  phase_swa(p, bid, nblk, lds);  PH_END
            wout = (const bf16_t*)(ws + WT_SWA_OUT);
        } else {
            PH_BEGIN  { pg8::DenseProb8 S{H8, ws + WT_CONV_IN, D, D, M / 256, 12, nblk, bid, 127, 122}; pg8::EpConvIn E{U, U2}; pg8::gemm_phase(lds, S, E, D); }  PH_END
            PH_BEGIN  phase_conv(p, bid, nblk);  PH_END
            wout = (const bf16_t*)(ws + WT_CONV_OUT);
        }
        PH_BEGIN  {
            if (l == 0) { pg8::DenseProb S{aout, wout, D, D, 0, M / 256, 4, nblk, bid}; pg8::EpResid E{(const bf16_t*)(ws + WS_XB), mod + (size_t)l * NB * 6 * D + 2 * D, XOUT, 1.f, 0}; pg8::gemm_phase(lds, S, E, D); }
            else { pg8::DenseProb8 S{(const unsigned char*)aout, (const unsigned char*)wout, D, D, M / 256, 4, nblk, bid, 127, 122};
                pg8::EpResid E{(const bf16_t*)(ws + WS_XB), mod + (size_t)l * NB * 6 * D + 2 * D, XOUT, 1.f / 256.f, 0}; pg8::gemm_phase(lds, S, E, D); } }  PH_END
        PH_BEGIN  phase_norm3(p, l, bid, nblk, ldsf, CNTL);  PH_END
        PH_BEGIN  {
            if (tid < 64) {
                const int c = tid < NE ? (int)__hip_atomic_load(ctl + CW_CNT + (l * 16 + tid) * 64, __ATOMIC_RELAXED, __HIP_MEMORY_SCOPE_AGENT) : 0;
                const int tl = (c + 255) >> 8; int ps = tl;
#pragma unroll
                for (int o = 1; o < 16; o <<= 1) { const int v = __shfl_up(ps, o); if ((tid & 63) >= o) ps += v; }
                if (tid < NE) { geo[tid] = ps - tl; geo[NE + 1 + tid] = c; }
                if (tid == NE - 1) geo[NE] = ps;
            }
            __syncthreads();
            const int ng1 = (l + 1 < DEPTH && l + 1 >= CVPRO) ? nblk - CV1 : nblk;
            if (bid < ng1) {
                pg8::MoeProb S{(const unsigned char*)H, ws + WT_GU + (size_t)l * NE * 2048 * 1024, (size_t)2048 * 1024, (const int*)(ws + WS_RTOK), geo, (const LAS unsigned*)(lds + LDS_ROWTAB), D, D, 8, ng1, bid, 1, 127, 122};
                S.fill_rowtab<0, 12>((LAS unsigned*)(lds + LDS_ROWTAB), tid); __syncthreads();
                pg8::EpSwiGlu E{(unsigned char*)ACT}; pg8::gemm_phase(lds, S, E, D);
            } else convert_moe(p, l + 1, 0, CVSPLIT, (bid - ng1) * NWV + (otid() >> 6), CV1 * NWV, lds + (otid() >> 6) * 16384, otid() & 63); }  PH_END
        PH_BEGIN  {
            if (tid < 64) {
                const int c = tid < NE ? (int)__hip_atomic_load(ctl + CW_CNT + (l * 16 + tid) * 64, __ATOMIC_RELAXED, __HIP_MEMORY_SCOPE_AGENT) : 0;
                const int tl = (c + 255) >> 8; int ps = tl;
#pragma unroll
                for (int o = 1; o < 16; o <<= 1) { const int v = __shfl_up(ps, o); if ((tid & 63) >= o) ps += v; }
                if (tid < NE) { geo[tid] = ps - tl; geo[NE + 1 + tid] = c; }
                if (tid == NE - 1) geo[NE] = ps;
            }
            __syncthreads();
            const int ng2 = (l + 1 < DEPTH && l + 1 >= CVPRO) ? nblk - CV2 : nblk;
            if (bid < ng2) {
                pg8::MoeProb S{(const unsigned char*)ACT, ws + WT_DN + (size_t)l * NE * 1024 * 1024, (size_t)1024 * 1024, (const int*)(ws + WS_RTOK), geo, (const LAS unsigned*)(lds + LDS_ROWTAB), FF, FF, 4, ng2, bid, 0, 124, 122};
                S.fill_rowtab<1, 6>((LAS unsigned*)(lds + LDS_ROWTAB), tid); __syncthreads();
                pg8::EpY8 E{(unsigned char*)Y, (const LAS unsigned*)(lds + LDS_ROWTAB)}; pg8::gemm_phase(lds, S, E, FF);
            } else convert_moe(p, l + 1, CVSPLIT, CV_LAYER_ITEMS, (bid - ng2) * NWV + (otid() >> 6), CV2 * NWV, lds + (otid() >> 6) * 16384, otid() & 63); }  PH_END
    }
    PH_BEGIN  phase_norm<2>(p, DEPTH, bid, nblk, ldsf, -1, XOUT);  PH_END
#undef PH_BEGIN
#undef PH_END
}

#ifndef MK_ONE_LAUNCH
#define MK_ONE_LAUNCH 1
#endif
extern "C" void kernel_launch(void* const* d_in, const int* in_sizes, int n_in, void* d_out, int out_size, void* d_ws, size_t ws_size, hipStream_t stream) {
    (void)in_sizes; (void)n_in; (void)out_size;
    if (ws_size < WS_END) return;
    P p{};
    const float* const* in = (const float* const*)d_in;
    p.x = in[0]; p.c = in[1]; p.ada_w = in[2]; p.ada_b = in[3]; p.norm_g = in[4]; p.final_norm_g = in[5];
    p.pool_w_in = in[6]; p.pool_w_grp = in[7]; p.pool_scale = in[8]; p.pool_w_out = in[9];
    p.hgrn_w_in = in[10]; p.hgrn_lb_logits = in[11]; p.hgrn_norm_g = in[12]; p.hgrn_w_out = in[13];
    p.swa_w_in = in[14]; p.swa_sinks = in[15]; p.swa_w_out = in[16];
    p.conv_w_in = in[17]; p.conv_w = in[18]; p.conv_w_out = in[19];
    p.router_w = in[20]; p.router_bias = in[21]; p.moe_w_gate = in[22]; p.moe_w_up = in[23]; p.moe_w_down = in[24];
    p.X = (float*)d_out; p.ws = (unsigned char*)d_ws;
    static int grid = 0;
    if (grid == 0) {
        int dev = 0, cus = 0;
        if (hipGetDevice(&dev) != hipSuccess || hipDeviceGetAttribute(&cus, hipDeviceAttributeMultiprocessorCount, dev) != hipSuccess) { grid = -1; return; }
        if (hipFuncSetAttribute((const void*)mega, hipFuncAttributeMaxDynamicSharedMemorySize, LDS_BYTES) != hipSuccess) { grid = -1; return; }
        grid = (cus >= 256) ? 256 : -1;
    }
    if (grid < 0) return;
    (void)hipMemsetAsync((unsigned char*)d_ws + WS_CTL, 0, CTL_BYTES, stream);
#if MK_ONE_LAUNCH
    hipLaunchKernelGGL(mega, dim3(grid), dim3(NT), LDS_BYTES, stream, p, 0, NPHASE);
#else
    for (int k = 0; k < NPHASE; ++k) hipLaunchKernelGGL(mega, dim3(grid), dim3(NT), LDS_BYTES, stream, p, k, k + 1);
#endif
}
```

```cpp
#include <hip/hip_runtime.h>
#include <stdint.h>

#define LAS __attribute__((address_space(3)))
typedef unsigned short bf16_t;
typedef short bf16x8 __attribute__((ext_vector_type(8)));
typedef float f32x4 __attribute__((ext_vector_type(4)));
typedef unsigned u32x2 __attribute__((ext_vector_type(2)));
typedef float f32x2_t __attribute__((ext_vector_type(2)));
typedef unsigned u32x4 __attribute__((ext_vector_type(4)));

constexpr int D = 1024, NB = 8, SEQ = 4096, M = NB * SEQ, DEPTH = 4;
constexpr int NE = 16, FF = 1024;
constexpr float EPS = 1e-6f;
constexpr int NT = 512, NWV = 8;
constexpr int RCAP = 32768;
constexpr int MAXSLOT = 69632;

constexpr size_t WS_CTL = 0;
constexpr size_t CTL_BYTES = 65536;
constexpr int CW_CNT = 4096;
constexpr size_t WS_MOD = WS_CTL + CTL_BYTES;
constexpr size_t WS_LB = WS_MOD + (size_t)4 * 8 * 6144 * 4;
constexpr size_t WS_TOKINFO = WS_LB + 4096;
constexpr size_t WS_RTOK = WS_TOKINFO + (size_t)M * 16;
constexpr size_t WS_H = WS_RTOK + (size_t)NE * RCAP * 4;
constexpr size_t WS_Z = WS_H + (size_t)M * D * 2;
constexpr size_t WS_O = WS_Z + (size_t)M * D * 2;
constexpr size_t WS_U = WS_O + (size_t)M * D * 2;
constexpr size_t U_BYTES = (size_t)272 << 20;
constexpr size_t WS_ACT = WS_U;
constexpr size_t WS_Y = WS_U + (size_t)MAXSLOT * FF * 2;
constexpr size_t WT_POOL_IN = WS_U + U_BYTES;
constexpr size_t WT_POOL_GRP = WT_POOL_IN + (size_t)1024 * 1024 * 2;
constexpr size_t WT_POOL_OUT = WT_POOL_GRP + (size_t)1024 * 256 * 2;
constexpr size_t WT_HGRN_IN = WT_POOL_OUT + (size_t)1024 * 1024 * 2;
constexpr size_t WT_HGRN_OUT = WT_HGRN_IN + (size_t)4096 * 1024 * 2;
constexpr size_t WT_SWA_IN = WT_HGRN_OUT + (size_t)1024 * 1024 * 2;
constexpr size_t WT_SWA_OUT = WT_SWA_IN + (size_t)1536 * 1024 * 2;
constexpr size_t WT_CONV_IN = WT_SWA_OUT + (size_t)1024 * 1024 * 2;
constexpr size_t WT_CONV_OUT = WT_CONV_IN + (size_t)3072 * 1024 * 2;
constexpr size_t WT_GU = WT_CONV_OUT + (size_t)1024 * 1024 * 2;
constexpr size_t WT_DN = WT_GU + (size_t)64 * 2048 * 1024;
constexpr size_t WT_POOL_W2 = WT_DN + (size_t)64 * 1024 * 1024;
constexpr size_t WS_XB = WT_POOL_W2 + (size_t)1024 * 1024 * 2;
constexpr size_t WS_END = WS_XB + (size_t)M * D * 2;

struct P {
    const float *x, *c, *ada_w, *ada_b, *norm_g, *final_norm_g;
    const float *pool_w_in, *pool_w_grp, *pool_scale, *pool_w_out;
    const float *hgrn_w_in, *hgrn_lb_logits, *hgrn_norm_g, *hgrn_w_out;
    const float *swa_w_in, *swa_sinks, *swa_w_out;
    const float *conv_w_in, *conv_w, *conv_w_out;
    const float *router_w, *router_bias, *moe_w_gate, *moe_w_up, *moe_w_down;
    float* X;
    unsigned char* ws;
};

__device__ __forceinline__ int otid() { int t = threadIdx.x; asm volatile("" : "+v"(t)); return t; }
__device__ __forceinline__ float bf2f(unsigned v) { return __uint_as_float(v << 16); }
__device__ __forceinline__ unsigned f2bf(float f) { unsigned u = __float_as_uint(f); return (u + 0x7fffu + ((u >> 16) & 1u)) >> 16; }
__device__ __forceinline__ unsigned pk2(float lo, float hi) { return f2bf(lo) | (f2bf(hi) << 16); }
__device__ __forceinline__ float bflo(unsigned w) { return __uint_as_float(w << 16); }
__device__ __forceinline__ float bfhi(unsigned w) { return __uint_as_float(w & 0xffff0000u); }
__device__ __forceinline__ float wave_sum(float v) {
#pragma unroll
    for (int o = 1; o < 64; o <<= 1) v += __shfl_xor(v, o);
    return v;
}
__device__ __forceinline__ float sigmoidf_(float x) { return 1.f / (1.f + __expf(-x)); }
__device__ __forceinline__ float siluf_(float x) { return x / (1.f + __expf(-x)); }

__device__ __forceinline__ float sat8(float v) { return __builtin_amdgcn_fmed3f(v, -448.f, 448.f); }
__device__ __forceinline__ unsigned pk8x4(float a, float b, float c, float d) { a = sat8(a); b = sat8(b); c = sat8(c); d = sat8(d); unsigned w = 0; w = __builtin_amdgcn_cvt_pk_fp8_f32(a, b, w, false); w = __builtin_amdgcn_cvt_pk_fp8_f32(c, d, w, true); return w; }
struct ExpGeo { int cnt[NE]; int tstart[NE + 1]; };
__device__ __forceinline__ void load_geo(unsigned* ctl, int layer, ExpGeo& g) {
    int acc = 0;
#pragma unroll
    for (int e = 0; e < NE; ++e) { const int c = (int)__hip_atomic_load(ctl + CW_CNT + (layer * 16 + e) * 64, __ATOMIC_RELAXED, __HIP_MEMORY_SCOPE_AGENT); g.cnt[e] = c; g.tstart[e] = acc; acc += (c + 255) >> 8; }
    g.tstart[NE] = acc;
}

__device__ __forceinline__ void phase_prep(const P& p, int bid, int nblk, float* lds) {
    float* cond = lds;
    float* red = lds + 8 * 1024;
    const int tid = otid(), wave = tid >> 6, lane = tid & 63;
    for (int i = tid; i < NB * D / 4; i += NT) { const f32x4 c4 = ((const f32x4*)p.c)[i]; f32x4 o; o.x = siluf_(c4.x); o.y = siluf_(c4.y); o.z = siluf_(c4.z); o.w = siluf_(c4.w); ((f32x4*)cond)[i] = o; }
    __syncthreads();
    float* mod = (float*)(p.ws + WS_MOD);
    const int nitems = DEPTH * (6 * D / 128);
    for (int it = nblk - 1 - bid; it < nitems; it += nblk) {
        const int l = it / 48, col = (it % 48) * 128 + 2 * lane;
        const float* w = p.ada_w + (size_t)l * D * 6 * D + (size_t)(wave * 128) * 6 * D + col;
        float a0[NB], a1[NB];
#pragma unroll
        for (int b = 0; b < NB; ++b) { a0[b] = 0.f; a1[b] = 0.f; }
        const float* cw = cond + wave * 128;
#pragma unroll 1
        for (int k0 = 0; k0 < 128; k0 += 8) {
            f32x2_t wv[8];
#pragma unroll
            for (int k = 0; k < 8; ++k) wv[k] = *(const f32x2_t*)(w + (size_t)(k0 + k) * 6 * D);
#pragma unroll
            for (int b = 0; b < NB; ++b) {
                const f32x4 c0 = *(const f32x4*)(cw + b * D + k0), c1 = *(const f32x4*)(cw + b * D + k0 + 4);
                a0[b] += (c0.x * wv[0].x + c0.y * wv[1].x) + (c0.z * wv[2].x + c0.w * wv[3].x) + (c1.x * wv[4].x + c1.y * wv[5].x) + (c1.z * wv[6].x + c1.w * wv[7].x);
                a1[b] += (c0.x * wv[0].y + c0.y * wv[1].y) + (c0.z * wv[2].y + c0.w * wv[3].y) + (c1.x * wv[4].y + c1.y * wv[5].y) + (c1.z * wv[6].y + c1.w * wv[7].y);
            }
        }
#pragma unroll
        for (int b = 0; b < NB; ++b) { f32x2_t v = {a0[b], a1[b]}; *(f32x2_t*)(red + (wave * NB + b) * 128 + 2 * lane) = v; }
        __syncthreads();
        {
            const int b = tid >> 6;
            f32x2_t s = {0.f, 0.f};
#pragma unroll
            for (int w2 = 0; w2 < NWV; ++w2) s += *(const f32x2_t*)(red + (w2 * NB + b) * 128 + 2 * lane);
            const f32x2_t bb = *(const f32x2_t*)(p.ada_b + (size_t)l * 6 * D + col);
            *(f32x2_t*)(mod + ((size_t)l * NB + b) * 6 * D + col) = s + bb;
        }
        __syncthreads();
    }
    if (bid == 0) {
        float* lb = (float*)(p.ws + WS_LB);
        for (int d = tid; d < D; d += NT) {
            const float a0 = p.hgrn_lb_logits[d], a1 = p.hgrn_lb_logits[D + d], a2 = p.hgrn_lb_logits[2 * D + d], a3 = p.hgrn_lb_logits[3 * D + d];
            const float mx = fmaxf(fmaxf(a0, a1), fmaxf(a2, a3));
            const float e0 = __expf(a0 - mx), e1 = __expf(a1 - mx), e2 = __expf(a2 - mx), e3 = __expf(a3 - mx);
            lb[d] = e1 / (e0 + e1 + e2 + e3);
        }
    }
}

template <int MODE>
__device__ __forceinline__ void phase_norm(const P& p, int layer, int bid, int nblk, float* lds, int cl = -1, bf16_t* Xo = nullptr) {
    (void)lds; (void)cl;
    bf16_t* Xb = (bf16_t*)(p.ws + WS_XB);
    if (!Xo) Xo = Xb;
    const int tid = otid(), wave = tid >> 6, lane = tid & 63;
    const int NGW = nblk * NWV, gw = bid * NWV + wave;
    const int RPW = M / NGW;
    const float* mod = (const float*)(p.ws + WS_MOD);
    unsigned* ctl = (unsigned*)(p.ws + WS_CTL);
    unsigned char* H = p.ws + WS_H;
    const unsigned char* Y8 = p.ws + WS_Y;
    const u32x4* tokinfo = (const u32x4*)(p.ws + WS_TOKINFO);
    const int row0 = gw * RPW, b = row0 / SEQ;
    const float* ng = (MODE == 2) ? p.final_norm_g : p.norm_g + (size_t)(layer * 2) * D;
    f32x4 gv[4], g2v[4], scv[4], shv[4];
#pragma unroll
    for (int j = 0; j < 4; ++j) {
        gv[j] = *(const f32x4*)(ng + j * 256 + 4 * lane);
        if (MODE == 1 || MODE == 2) g2v[j] = *(const f32x4*)(mod + ((size_t)(layer - 1) * NB + b) * 6 * D + 5 * D + j * 256 + 4 * lane) * 0.125f;
        if (MODE != 2) { const float* sh = mod + ((size_t)layer * NB + b) * 6 * D; shv[j] = *(const f32x4*)(sh + j * 256 + 4 * lane); scv[j] = 1.f + *(const f32x4*)(sh + D + j * 256 + 4 * lane); gv[j] = gv[j] * scv[j]; }
    }
    u32x4 ti_n = {0u, 0u, 0u, 0u};
    f32x4 vx[4]; unsigned y0[4], y1[4]; float w0 = 0.f, w1 = 0.f;
#define NORM_LOAD(R) do { const int r_ = (R); \
        if (MODE == 0) { _Pragma("unroll") for (int j = 0; j < 4; ++j) vx[j] = *(const f32x4*)(p.x + (size_t)r_ * D + j * 256 + 4 * lane); } \
        else { _Pragma("unroll") for (int j = 0; j < 4; ++j) { const u32x2 q = *(const u32x2*)(Xb + (size_t)r_ * D + j * 256 + 4 * lane); vx[j] = (f32x4){bflo(q.x), bfhi(q.x), bflo(q.y), bfhi(q.y)}; } } \
        if (MODE == 1 || MODE == 2) { const u32x4 ti = ti_n; w0 = __uint_as_float(ti.z); w1 = __uint_as_float(ti.w); \
            _Pragma("unroll") for (int j = 0; j < 4; ++j) { y0[j] = *(const unsigned*)(Y8 + (size_t)r_ * 2 * D + j * 256 + 4 * lane); y1[j] = *(const unsigned*)(Y8 + (size_t)r_ * 2 * D + D + j * 256 + 4 * lane); } \
            if (r_ + 1 < row0 + RPW) ti_n = tokinfo[r_ + 1]; } } while (0)
    if (MODE == 1 || MODE == 2) ti_n = tokinfo[row0];
    NORM_LOAD(row0);
    for (int row = row0; row < row0 + RPW; ++row) {
        f32x4 v[4];
#pragma unroll
        for (int j = 0; j < 4; ++j) {
            v[j] = vx[j];
            if (MODE == 1 || MODE == 2) {
                const f32x2_t a0 = __builtin_amdgcn_cvt_pk_f32_fp8(y0[j], false), a1 = __builtin_amdgcn_cvt_pk_f32_fp8(y0[j], true);
                const f32x2_t b0 = __builtin_amdgcn_cvt_pk_f32_fp8(y1[j], false), b1 = __builtin_amdgcn_cvt_pk_f32_fp8(y1[j], true);
                v[j].x += g2v[j].x * (w0 * a0.x + w1 * b0.x);
                v[j].y += g2v[j].y * (w0 * a0.y + w1 * b0.y);
                v[j].z += g2v[j].z * (w0 * a1.x + w1 * b1.x);
                v[j].w += g2v[j].w * (w0 * a1.y + w1 * b1.y);
            }
        }
        if (row + 1 < row0 + RPW) NORM_LOAD(row + 1);
        float ss = 0.f;
#pragma unroll
        for (int j = 0; j < 4; ++j) ss += (v[j].x * v[j].x + v[j].y * v[j].y) + (v[j].z * v[j].z + v[j].w * v[j].w);
        const float rstd = rsqrtf(wave_sum(ss) * (1.f / D) + EPS);
        if (MODE == 2) {
            float* o = ((Xo == Xb) ? p.X : (float*)Xo) + (size_t)row * D;
#pragma unroll
            for (int j = 0; j < 4; ++j) *(f32x4*)(o + j * 256 + 4 * lane) = v[j] * rstd * gv[j];
        } else {
            bf16_t* o = Xo + (size_t)row * D;
#pragma unroll
            for (int j = 0; j < 4; ++j) {
                { u32x2 xw; xw.x = pk2(v[j].x, v[j].y); xw.y = pk2(v[j].z, v[j].w); *(u32x2*)(o + j * 256 + 4 * lane) = xw; }
                const f32x4 h = v[j] * rstd * gv[j] + shv[j];
                const unsigned w = pk8x4(h.x, h.y, h.z, h.w);
                *(unsigned*)(H + (size_t)row * D + j * 256 + 4 * lane) = w;
            }
        }
    }
#undef NORM_LOAD
}

constexpr int N3_WP = 0;
constexpr int N3_RED = 64 * 272;
constexpr int N3_BIAS = N3_RED + 512;
constexpr int N3_LG = N3_BIAS + 16;
constexpr int N3_WCNT = N3_LG + 8 * 272;
constexpr int N3_BBASE = N3_WCNT + 128;
__device__ __forceinline__ void phase_norm3(const P& p, int layer, int bid, int nblk, float* lds, int cl = -1, const int N3PROBE = 0) {
    if (cl < 0) cl = layer;
    const int tid = otid(), wave = tid >> 6, lane = tid & 63, m = lane & 15, kq = lane >> 4;
    const float* mod = (const float*)(p.ws + WS_MOD);
    unsigned* ctl = (unsigned*)(p.ws + WS_CTL);
    unsigned char* H8 = p.ws + WS_H;
    u32x4* tokinfo = (u32x4*)(p.ws + WS_TOKINFO);
    int* rtok = (int*)(p.ws + WS_RTOK);
    const float* ng = p.norm_g + (size_t)(layer * 2 + 1) * D;
    int* wcnt = (int*)(lds + N3_WCNT);
    int* bbase = (int*)(lds + N3_BBASE);
    float rb[NE];
#pragma unroll
    for (int e = 0; e < NE; ++e) rb[e] = p.router_bias[e];
    for (int grp = bid; grp < M / 128; grp += nblk) {
        const int b = (grp * 128) / SEQ;
        const float* sh = mod + ((size_t)layer * NB + b) * 6 * D + 3 * D;
        const float* sc = sh + D;
        const int R0 = grp * 128 + wave * 16;
        const bf16_t* xr = (const bf16_t*)(p.ws + WS_XB) + (size_t)(R0 + m) * D + 8 * kq;
        f32x4 d0 = {0.f, 0.f, 0.f, 0.f}, d1 = {0.f, 0.f, 0.f, 0.f};
        float ss = 0.f;
        u32x4 xs[8];
#pragma unroll
        for (int s = 0; s < 8; ++s) xs[s] = *(const u32x4*)(xr + s * 32);
        {
#pragma unroll 2
            for (int i = 0; i < 4; ++i) {
                const int sl = tid + i * NT, g8 = sl >> 4, e = sl & 15, c0 = g8 * 8;
                const f32x4 ga = *(const f32x4*)(ng + c0), gb = *(const f32x4*)(ng + c0 + 4), sa = *(const f32x4*)(sc + c0), sb = *(const f32x4*)(sc + c0 + 4);
                float r[8];
#pragma unroll
                for (int j = 0; j < 8; ++j) r[j] = p.router_w[(c0 + j) * NE + e];
                const f32x4 wa = ga * (1.f + sa), wb = gb * (1.f + sb);
                const float w[8] = {r[0] * wa.x, r[1] * wa.y, r[2] * wa.z, r[3] * wa.w, r[4] * wb.x, r[5] * wb.y, r[6] * wb.z, r[7] * wb.w};
                u32x4 hi, lo;
                hi.x = pk2(w[0], w[1]); hi.y = pk2(w[2], w[3]); hi.z = pk2(w[4], w[5]); hi.w = pk2(w[6], w[7]);
                lo.x = pk2(w[0] - bflo(hi.x), w[1] - bfhi(hi.x)); lo.y = pk2(w[2] - bflo(hi.y), w[3] - bfhi(hi.y));
                lo.z = pk2(w[4] - bflo(hi.z), w[5] - bfhi(hi.z)); lo.w = pk2(w[6] - bflo(hi.w), w[7] - bfhi(hi.w));
                *(u32x4*)((char*)lds + sl * 16) = hi; *(u32x4*)((char*)lds + 32768 + sl * 16) = lo;
            }
            float bp[NE];
#pragma unroll
            for (int e = 0; e < NE; ++e) bp[e] = 0.f;
#pragma unroll
            for (int q = 0; q < 2; ++q) {
                const int c = tid + q * NT;
                const float shc = sh[c];
                const f32x4 r0 = *(const f32x4*)(p.router_w + c * NE), r1 = *(const f32x4*)(p.router_w + c * NE + 4), r2 = *(const f32x4*)(p.router_w + c * NE + 8), r3 = *(const f32x4*)(p.router_w + c * NE + 12);
                bp[0] += shc * r0.x; bp[1] += shc * r0.y; bp[2] += shc * r0.z; bp[3] += shc * r0.w; bp[4] += shc * r1.x; bp[5] += shc * r1.y; bp[6] += shc * r1.z; bp[7] += shc * r1.w;
                bp[8] += shc * r2.x; bp[9] += shc * r2.y; bp[10] += shc * r2.z; bp[11] += shc * r2.w; bp[12] += shc * r3.x; bp[13] += shc * r3.y; bp[14] += shc * r3.z; bp[15] += shc * r3.w;
            }
#pragma unroll
            for (int e = 0; e < NE; ++e) {
#pragma unroll
                for (int o = 1; o < 64; o <<= 1) bp[e] += __shfl_xor(bp[e], o);
            }
            if (lane == 0) {
#pragma unroll
                for (int e = 0; e < NE; ++e) lds[N3_RED + wave * 16 + e] = bp[e];
            }
        }
        __syncthreads();
        if (tid < NE) { float pr[NWV];
#pragma unroll
            for (int q = 0; q < NWV; ++q) pr[q] = lds[N3_RED + q * 16 + tid];
            __builtin_amdgcn_sched_barrier(0);
            lds[N3_BIAS + tid] = ((pr[0] + pr[1]) + (pr[2] + pr[3])) + ((pr[4] + pr[5]) + (pr[6] + pr[7])); }
        __syncthreads();
#pragma unroll
        for (int s = 0; s < 32; ++s) {
            const u32x4 q = xs[s & 7];
            if (s + 8 < 32) xs[s & 7] = *(const u32x4*)(xr + (s + 8) * 32);
            const u32x4 bh = *(const u32x4*)((const char*)lds + ((s * 4 + kq) * 16 + m) * 16), bl = *(const u32x4*)((const char*)lds + 32768 + ((s * 4 + kq) * 16 + m) * 16);
            const float x0 = bflo(q.x), x1 = bfhi(q.x), x2 = bflo(q.y), x3 = bfhi(q.y), x4 = bflo(q.z), x5 = bfhi(q.z), x6 = bflo(q.w), x7 = bfhi(q.w);
            ss += ((x0 * x0 + x1 * x1) + (x2 * x2 + x3 * x3)) + ((x4 * x4 + x5 * x5) + (x6 * x6 + x7 * x7));
            d0 = __builtin_amdgcn_mfma_f32_16x16x32_bf16(__builtin_bit_cast(bf16x8, q), __builtin_bit_cast(bf16x8, bh), d0, 0, 0, 0);
            d1 = __builtin_amdgcn_mfma_f32_16x16x32_bf16(__builtin_bit_cast(bf16x8, q), __builtin_bit_cast(bf16x8, bl), d1, 0, 0, 0);
        }
        ss += __shfl_xor(ss, 16); ss += __shfl_xor(ss, 32);
        const float rstd = rsqrtf(ss * (1.f / D) + EPS);
#define N3COL(q) (((q) >> 1) * 512 + 8 * lane + 4 * ((q) & 1))
        f32x4 gsv[4], shv[4];
#pragma unroll
        for (int q = 0; q < 4; ++q) { const f32x4 g4 = *(const f32x4*)(ng + N3COL(q)), s1 = *(const f32x4*)(sc + N3COL(q)); gsv[q] = g4 * (1.f + s1); shv[q] = *(const f32x4*)(sh + N3COL(q)); }
        const bf16_t* xq = (const bf16_t*)(p.ws + WS_XB) + (size_t)R0 * D;
        u32x4 xp[4][2];
#pragma unroll
        for (int r = 0; r < 4; ++r)
#pragma unroll
            for (int j = 0; j < 2; ++j) xp[r][j] = *(const u32x4*)(xq + (size_t)r * D + j * 512 + 8 * lane);
        {
            const f32x4 d = d0 + d1; const float be = lds[N3_BIAS + m];
            float* lg = lds + N3_LG + wave * 272;
#pragma unroll
            for (int i = 0; i < 4; ++i) { const float rs = __shfl(rstd, 4 * kq + i); lg[(4 * kq + i) * 17 + m] = rs * d[i] + be; }
        }
        asm volatile("s_waitcnt lgkmcnt(0)" ::: "memory");
        int my_e0 = -1, my_e1 = -1, my_row = -1; float my_w0 = 0.f, my_w1 = 0.f;
        {
            float lgt[NE];
            const float* lg = lds + N3_LG + wave * 272 + m * 17;
#pragma unroll
            for (int e = 0; e < NE; ++e) lgt[e] = lg[e];
                float sc_[NE], sel[NE];
#pragma unroll
                for (int e = 0; e < NE; ++e) { const float lg = lgt[e]; sc_[e] = sigmoidf_(lg); sel[e] = sc_[e] + rb[e]; }
                float gs[4];
#pragma unroll
                for (int g = 0; g < 4; ++g) {
                    const float a = sel[4 * g], b2 = sel[4 * g + 1], c2 = sel[4 * g + 2], d2 = sel[4 * g + 3];
                    const float hi1 = fmaxf(a, b2), lo1 = fminf(a, b2), hi2 = fmaxf(c2, d2), lo2 = fminf(c2, d2);
                    gs[g] = fmaxf(hi1, hi2) + fmaxf(fminf(hi1, hi2), fmaxf(lo1, lo2));
                }
                int best = 0; float bs = gs[0];
#pragma unroll
                for (int g = 1; g < 4; ++g) if (gs[g] > bs) { bs = gs[g]; best = g; }
                float s4[4], p4[4];
#pragma unroll
                for (int i = 0; i < 4; ++i) {
                    s4[i] = best == 0 ? sel[i] : best == 1 ? sel[4 + i] : best == 2 ? sel[8 + i] : sel[12 + i];
                    p4[i] = best == 0 ? sc_[i] : best == 1 ? sc_[4 + i] : best == 2 ? sc_[8 + i] : sc_[12 + i];
                }
                int i0 = 0; float m0 = s4[0], q0 = p4[0];
#pragma unroll
                for (int i = 1; i < 4; ++i) if (s4[i] > m0) { m0 = s4[i]; i0 = i; q0 = p4[i]; }
                int i1 = -1; float m1 = -INFINITY, q1 = 0.f;
#pragma unroll
                for (int i = 0; i < 4; ++i) if (i != i0 && s4[i] > m1) { m1 = s4[i]; i1 = i; q1 = p4[i]; }
            const float inv = 1.f / (q0 + q1);
            if (lane < 16) { my_e0 = best * 4 + i0; my_e1 = best * 4 + i1; my_w0 = q0 * inv; my_w1 = q1 * inv; my_row = R0 + lane; }
        }
        if (N3PROBE != 1) {
#pragma unroll
            for (int r = 0; r < 16; ++r) {
                const float rs = __shfl(rstd, r);
                u32x4 q[2];
#pragma unroll
                for (int j = 0; j < 2; ++j) q[j] = xp[r & 3][j];
                if (r + 4 < 16) {
#pragma unroll
                    for (int j = 0; j < 2; ++j) xp[r & 3][j] = *(const u32x4*)(xq + (size_t)(r + 4) * D + j * 512 + 8 * lane); }
#pragma unroll
                for (int j = 0; j < 2; ++j) {
                    const f32x4 h0 = (f32x4){bflo(q[j].x), bfhi(q[j].x), bflo(q[j].y), bfhi(q[j].y)} * rs * gsv[2 * j] + shv[2 * j];
                    const f32x4 h1 = (f32x4){bflo(q[j].z), bfhi(q[j].z), bflo(q[j].w), bfhi(q[j].w)} * rs * gsv[2 * j + 1] + shv[2 * j + 1];
                    u32x2 w; w.x = pk8x4(h0.x, h0.y, h0.z, h0.w); w.y = pk8x4(h1.x, h1.y, h1.z, h1.w);
                    *(u32x2*)(H8 + (size_t)(R0 + r) * D + j * 512 + 8 * lane) = w; }
            }
        }
#undef N3COL
        const unsigned long long lt = (1ull << lane) - 1ull;
        int mycount = 0;
#pragma unroll
        for (int e = 0; e < NE; ++e) {
            const unsigned long long m0 = __ballot(my_e0 == e), m1 = __ballot(my_e1 == e);
            const int c = __popcll(m0) + __popcll(m1);
            if (lane == e) mycount = c;
        }
        if (lane < NE) wcnt[wave * NE + lane] = mycount;
        __syncthreads();
        if (tid < NE) {
            int tot = 0;
#pragma unroll
            for (int w2 = 0; w2 < NWV; ++w2) tot += wcnt[w2 * NE + tid];
            bbase[tid] = (cl >= 8) ? 0 : (int)atomicAdd(ctl + CW_CNT + (cl * 16 + tid) * 64, (unsigned)tot);
        }
        __syncthreads();
        int pos0 = 0, pos1 = 0;
#pragma unroll
        for (int e = 0; e < NE; ++e) {
            int be = bbase[e];
            for (int w2 = 0; w2 < wave; ++w2) be += wcnt[w2 * NE + e];
            const unsigned long long m0 = __ballot(my_e0 == e), m1 = __ballot(my_e1 == e);
            if (my_e0 == e) pos0 = be + __popcll(m0 & lt);
            if (my_e1 == e) pos1 = be + __popcll(m0) + __popcll(m1 & lt);
        }
        if (my_row >= 0) {
            rtok[my_e0 * RCAP + pos0] = my_row * 2; rtok[my_e1 * RCAP + pos1] = my_row * 2 + 1;
            u32x4 ti; ti.x = ((unsigned)my_e0 << 16) | (unsigned)pos0; ti.y = ((unsigned)my_e1 << 16) | (unsigned)pos1; ti.z = __float_as_uint(my_w0); ti.w = __float_as_uint(my_w1);
            tokinfo[my_row] = ti;
        }
        __syncthreads();
    }
}

__device__ __forceinline__ void phase_pool(const P& p, int bid, int nblk) {
    const bf16_t* U0 = (const bf16_t*)(p.ws + WS_U);
    bf16_t* P0 = (bf16_t*)(p.ws + WS_U + ((size_t)64 << 20));
    const int nitem = 128 * (M / 32);
    for (int it = bid * NT + otid(); it < nitem; it += nblk * NT) {
        const int ch = it & 127, seg = it >> 7;
        const int col = ch * 8, g = col >> 8, w = 2 << g;
        const int t0 = seg * 32, tb = t0 & (SEQ - 1);
        float s[8];
#pragma unroll
        for (int i = 0; i < 8; ++i) s[i] = 0.f;
        for (int i = 1; i < w; ++i) if (tb - i >= 0) {
            const u32x4 v = *(const u32x4*)(U0 + (size_t)(t0 - i) * D + col);
            s[0] += bflo(v.x); s[1] += bfhi(v.x); s[2] += bflo(v.y); s[3] += bfhi(v.y); s[4] += bflo(v.z); s[5] += bfhi(v.z); s[6] += bflo(v.w); s[7] += bfhi(v.w);
        }
        const u32x4 zero4 = {0u, 0u, 0u, 0u};
        u32x4 vs[4], qs[4];
#define POOL_LOAD(S, R) do { const int r_ = (R); vs[S] = *(const u32x4*)(U0 + (size_t)(t0 + r_) * D + col); \
            qs[S] = (tb + r_ + 1 - w >= 0) ? *(const u32x4*)(U0 + (size_t)(t0 + r_ + 1 - w) * D + col) : zero4; } while (0)
#pragma unroll
        for (int s4 = 0; s4 < 4; ++s4) POOL_LOAD(s4, s4);
#pragma unroll
        for (int r = 0; r < 32; ++r) {
            const int t = t0 + r, tp = tb + r;
            const u32x4 v = vs[r & 3], q = qs[r & 3];
            if (r + 4 < 32) POOL_LOAD(r & 3, r + 4);
            float u[8] = {bflo(v.x), bfhi(v.x), bflo(v.y), bfhi(v.y), bflo(v.z), bfhi(v.z), bflo(v.w), bfhi(v.w)};
            const float inv = 1.f / (float)(tp + 1 < w ? tp + 1 : w);
            float o[8];
#pragma unroll
            for (int i = 0; i < 8; ++i) { s[i] += u[i]; o[i] = s[i] * inv - u[i]; }
            u32x4 ov; ov.x = pk2(o[0], o[1]); ov.y = pk2(o[2], o[3]); ov.z = pk2(o[4], o[5]); ov.w = pk2(o[6], o[7]);
            *(u32x4*)(P0 + (size_t)t * D + col) = ov;
            s[0] -= bflo(q.x); s[1] -= bfhi(q.x); s[2] -= bflo(q.y); s[3] -= bfhi(q.y); s[4] -= bflo(q.z); s[5] -= bfhi(q.z); s[6] -= bflo(q.w); s[7] -= bfhi(q.w);
        }
#undef POOL_LOAD
    }
}

__device__ __forceinline__ void phase_hgrn_gate(const P& p, int bid, int nblk) {
    const int tid = otid(), wave = tid >> 6, lane = tid & 63;
    const int NGW = nblk * NWV, RPW = M / NGW, row0 = (bid * NWV + wave) * RPW;
    const bf16_t* O = (const bf16_t*)(p.ws + WS_O);
    const bf16_t* U1 = (const bf16_t*)(p.ws + WS_U);
    unsigned char* Z = p.ws + WS_Z;
    float ngv[16];
#pragma unroll
    for (int i = 0; i < 16; ++i) ngv[i] = p.hgrn_norm_g[(lane & 7) * 16 + i];
    u32x4 ra0[4], ra1[4], rg0[4], rg1[4];
#define GATE_LOAD(S, R) do { const size_t r_ = (size_t)(R); ra0[S] = *(const u32x4*)(O + r_ * D + lane * 16); ra1[S] = *(const u32x4*)(O + r_ * D + lane * 16 + 8); \
        rg0[S] = *(const u32x4*)(U1 + r_ * 4096 + 3072 + lane * 16); rg1[S] = *(const u32x4*)(U1 + r_ * 4096 + 3072 + lane * 16 + 8); } while (0)
#pragma unroll
    for (int s = 0; s < 4; ++s) GATE_LOAD(s, row0 + s);
#pragma unroll
    for (int rr = 0; rr < 16; ++rr) {
        const int row = row0 + rr;
        const u32x4 a0 = ra0[rr & 3], a1 = ra1[rr & 3], g0 = rg0[rr & 3], g1 = rg1[rr & 3];
        if (rr + 4 < 16) GATE_LOAD(rr & 3, row + 4);
        float o[16] = {bflo(a0.x), bfhi(a0.x), bflo(a0.y), bfhi(a0.y), bflo(a0.z), bfhi(a0.z), bflo(a0.w), bfhi(a0.w),
                       bflo(a1.x), bfhi(a1.x), bflo(a1.y), bfhi(a1.y), bflo(a1.z), bfhi(a1.z), bflo(a1.w), bfhi(a1.w)};
        float sg[16] = {bflo(g0.x), bfhi(g0.x), bflo(g0.y), bfhi(g0.y), bflo(g0.z), bfhi(g0.z), bflo(g0.w), bfhi(g0.w),
                        bflo(g1.x), bfhi(g1.x), bflo(g1.y), bfhi(g1.y), bflo(g1.z), bfhi(g1.z), bflo(g1.w), bfhi(g1.w)};
        float ss = 0.f;
#pragma unroll
        for (int i = 0; i < 16; ++i) ss += o[i] * o[i];
        ss += __shfl_xor(ss, 1); ss += __shfl_xor(ss, 2); ss += __shfl_xor(ss, 4);
        const float rstd = rsqrtf(ss * (1.f / 128.f) + EPS);
        float z[16];
#pragma unroll
        for (int i = 0; i < 16; ++i) z[i] = o[i] * (rstd * 8.f) * ngv[i] * sg[i];
        u32x4 z0; z0.x = pk8x4(z[0], z[1], z[2], z[3]); z0.y = pk8x4(z[4], z[5], z[6], z[7]); z0.z = pk8x4(z[8], z[9], z[10], z[11]); z0.w = pk8x4(z[12], z[13], z[14], z[15]);
        *(u32x4*)(Z + (size_t)row * D + lane * 16) = z0;
    }
#undef GATE_LOAD
}

__device__ __forceinline__ void phase_conv(const P& p, int bid, int nblk) {
    const bf16_t* Bg = (const bf16_t*)(p.ws + WS_U);
    const bf16_t* CU = (const bf16_t*)(p.ws + WS_U + ((size_t)64 << 20));
    unsigned char* Z = p.ws + WS_Z;
    const int nitem = M * 128, step = nblk * NT;
    int it = bid * NT + otid();
    if (it >= nitem) return;
    const int col = (it & 127) * 8;
    f32x4 cw[3][2];
#pragma unroll
    for (int j = 0; j < 3; ++j) { cw[j][0] = *(const f32x4*)(p.conv_w + j * D + col); cw[j][1] = *(const f32x4*)(p.conv_w + j * D + col + 4); }
    u32x4 sc0[4], sc1[4], sc2[4], sbv[4];
#define CONV_LOAD(S, IT) do { const int t_ = (IT) >> 7, tp_ = t_ & (SEQ - 1); const u32x4 z_ = {0u, 0u, 0u, 0u}; \
        sc0[S] = (tp_ >= 2) ? *(const u32x4*)(CU + (size_t)(t_ - 2) * D + col) : z_; sc1[S] = (tp_ >= 1) ? *(const u32x4*)(CU + (size_t)(t_ - 1) * D + col) : z_; \
        sc2[S] = *(const u32x4*)(CU + (size_t)t_ * D + col); sbv[S] = *(const u32x4*)(Bg + (size_t)t_ * D + col); } while (0)
#pragma unroll
    for (int s = 0; s < 4; ++s) CONV_LOAD(s, it + s * step);
#pragma unroll
    for (int k = 0; k < 32; ++k) {
        const int cur = it + k * step, t = cur >> 7;
        const u32x4 a0 = sc0[k & 3], a1 = sc1[k & 3], a2 = sc2[k & 3], ab = sbv[k & 3];
        if (k + 4 < 32) CONV_LOAD(k & 3, cur + 4 * step);
        float acc[8];
        acc[0] = cw[0][0].x * bflo(a0.x) + cw[1][0].x * bflo(a1.x) + cw[2][0].x * bflo(a2.x); acc[1] = cw[0][0].y * bfhi(a0.x) + cw[1][0].y * bfhi(a1.x) + cw[2][0].y * bfhi(a2.x);
        acc[2] = cw[0][0].z * bflo(a0.y) + cw[1][0].z * bflo(a1.y) + cw[2][0].z * bflo(a2.y); acc[3] = cw[0][0].w * bfhi(a0.y) + cw[1][0].w * bfhi(a1.y) + cw[2][0].w * bfhi(a2.y);
        acc[4] = cw[0][1].x * bflo(a0.z) + cw[1][1].x * bflo(a1.z) + cw[2][1].x * bflo(a2.z); acc[5] = cw[0][1].y * bfhi(a0.z) + cw[1][1].y * bfhi(a1.z) + cw[2][1].y * bfhi(a2.z);
        acc[6] = cw[0][1].z * bflo(a0.w) + cw[1][1].z * bflo(a1.w) + cw[2][1].z * bflo(a2.w); acc[7] = cw[0][1].w * bfhi(a0.w) + cw[1][1].w * bfhi(a1.w) + cw[2][1].w * bfhi(a2.w);
        u32x2 o; o.x = pk8x4(acc[0] * bflo(ab.x) * 8.f, acc[1] * bfhi(ab.x) * 8.f, acc[2] * bflo(ab.y) * 8.f, acc[3] * bfhi(ab.y) * 8.f);
        o.y = pk8x4(acc[4] * bflo(ab.z) * 8.f, acc[5] * bfhi(ab.z) * 8.f, acc[6] * bflo(ab.w) * 8.f, acc[7] * bfhi(ab.w) * 8.f);
        *(u32x2*)(Z + (size_t)t * D + col) = o;
    }
#undef CONV_LOAD
}

namespace pg8 {
constexpr int BM = 256, BK = 64, HALF = 128, HTB = HALF * BK * 2, STAGE_BYTES = 8 * HTB;
__device__ __forceinline__ int lds_byte(int r, int c) { const int st = (r >> 4) * 2 + (c >> 5), rr = r & 15, cc = c & 31, ob = rr * 64 + cc * 2; return st * 1024 + (ob ^ (((ob >> 9) & 1) << 5)); }
__device__ __forceinline__ void stage_rc(int b, int& R, int& C) { const int st = b / 1024, sb = b % 1024, swz = sb ^ (((sb >> 9) & 1) << 5); R = (st >> 1) * 16 + swz / 64; C = (st & 1) * 32 + (swz % 64) / 2; }
__device__ __forceinline__ int perm32(int rho) { const int n = rho >> 4, i = rho & 15; return 8 * (i >> 2) + 4 * n + (i & 3); }
struct Unit { int pm, pn, e, ui; };
typedef f32x4 Acc[2][2][4][2];

struct DenseProb {
    static constexpr int esz = 2;
    const bf16_t* A; const bf16_t* Bt; int lda, ldb, acol_pn, nM, nN, G, c;
    __device__ __forceinline__ bool next(int i, Unit& u) const { const int l = i * (G >> 3) + (c >> 3), rr = l / nN; u.pn = l - rr * nN; u.pm = rr * 8 + (c & 7); u.e = 0; u.ui = i; return u.pm < nM; }
    __device__ __forceinline__ void a_off(const Unit& u, const int (&R)[2], const int (&C)[2], unsigned (&off)[2][2]) const {
#pragma unroll
        for (int h = 0; h < 2; ++h)
#pragma unroll
            for (int i = 0; i < 2; ++i) off[h][i] = (unsigned)((u.pm * 256 + h * 128 + R[i]) * lda + u.pn * acol_pn + C[i]) * 2u;
    }
    __device__ __forceinline__ const char* a_base() const { return (const char*)A; }
    __device__ __forceinline__ const char* b_base(const Unit& u) const { return (const char*)Bt + (size_t)u.pn * 256 * ldb * 2; }
};
struct DenseProb8 {
    static constexpr int esz = 1;
    const unsigned char* A; const unsigned char* Bt; int lda, ldb, nM, nN, G, c, sa, sb;
    __device__ __forceinline__ bool next(int i, Unit& u) const { const int l = i * (G >> 3) + (c >> 3), rr = l / nN; u.pn = l - rr * nN; u.pm = rr * 8 + (c & 7); u.e = 0; u.ui = i; return u.pm < nM; }
    __device__ __forceinline__ void a_off(const Unit& u, const int (&R)[2], const int (&C)[2], unsigned (&off)[2][2]) const {
#pragma unroll
        for (int h = 0; h < 2; ++h)
#pragma unroll
            for (int i = 0; i < 2; ++i) off[h][i] = (unsigned)((u.pm * 256 + h * 128 + R[i]) * lda + 2 * C[i]);
    }
    __device__ __forceinline__ const char* a_base() const { return (const char*)A; }
    __device__ __forceinline__ const char* b_base(const Unit& u) const { return (const char*)Bt + (size_t)u.pn * 256 * ldb; }
};
struct MoeProb {
    static constexpr int esz = 1;
    const unsigned char* A; const unsigned char* Bt; size_t bstride; const int* rtok; const LAS int* geo; const LAS unsigned* rowtab; int lda, ldb, nN, G, c, gather, sa, sb;
    __device__ __forceinline__ bool next(int i, Unit& u) const {
        const int RT = geo[NE], npx = (RT + 7) >> 3;
        const int l = i * (G >> 3) + (c >> 3), rr = l / nN; u.pn = l - rr * nN; u.pm = (c & 7) * npx + rr; u.ui = i;
        int e = 0;
#pragma unroll
        for (int k = 1; k < NE; ++k) e += (u.pm >= geo[k]) ? 1 : 0;
        u.e = e; return rr < npx && u.pm < RT;
    }
    template <int SCAT, int NU> __device__ __forceinline__ void fill_rowtab(LAS unsigned* tab, int tid) const {
        if (tid < 256) {
            int tok[NU];
#pragma unroll
            for (int i = 0; i < NU; ++i) { Unit u; const bool ok = next(i, u); const int pos = (u.pm - geo[u.e]) * 256 + tid, cnt = geo[NE + 1 + u.e]; tok[i] = (ok && pos < cnt) ? rtok[u.e * RCAP + pos] : (SCAT ? 2 * M + tid : 0); }
#pragma unroll
            for (int i = 0; i < NU; ++i) tab[i * 256 + tid] = SCAT ? (unsigned)tok[i] * (unsigned)D : (unsigned)((tok[i] >> 1) * lda);
        }
    }
    __device__ __forceinline__ void a_off(const Unit& u, const int (&R)[2], const int (&C)[2], unsigned (&off)[2][2]) const {
        if (gather) {
#pragma unroll
            for (int h = 0; h < 2; ++h)
#pragma unroll
                for (int i = 0; i < 2; ++i) off[h][i] = rowtab[u.ui * 256 + h * 128 + R[i]] + (unsigned)(2 * C[i]);
        } else {
#pragma unroll
            for (int h = 0; h < 2; ++h)
#pragma unroll
                for (int i = 0; i < 2; ++i) off[h][i] = (unsigned)((u.pm * 256 + h * 128 + R[i]) * lda + 2 * C[i]);
        }
    }
    __device__ __forceinline__ const char* a_base() const { return (const char*)A; }
    __device__ __forceinline__ const char* b_base(const Unit& u) const { return (const char*)Bt + ((size_t)u.e * bstride + (size_t)u.pn * 256 * ldb); }
};

__device__ __forceinline__ unsigned cvt_pk_bf16(float lo, float hi) { unsigned r; asm volatile("v_cvt_pk_bf16_f32 %0, %1, %2" : "=v"(r) : "v"(lo), "v"(hi)); return r; }
__device__ __forceinline__ u32x4 pack8(const f32x4 v0, const f32x4 v1) { u32x4 w; w.x = cvt_pk_bf16(v0[0], v0[1]); w.y = cvt_pk_bf16(v0[2], v0[3]); w.z = cvt_pk_bf16(v1[0], v1[1]); w.w = cvt_pk_bf16(v1[2], v1[3]); return w; }
__device__ __forceinline__ float sigm(float x) { return __builtin_amdgcn_rcpf(1.f + __expf(-x)); }
__device__ __forceinline__ f32x4 silu4(f32x4 v) { f32x4 o; o[0] = v[0] * sigm(v[0]); o[1] = v[1] * sigm(v[1]); o[2] = v[2] * sigm(v[2]); o[3] = v[3] * sigm(v[3]); return o; }

__device__ __forceinline__ unsigned pk_fp8x4(float a, float b, float c, float d) { return pk8x4(a, b, c, d); }
#define ST16(ptr, val) (*(u32x4*)(ptr) = (val))
struct EpPlain { static constexpr bool PERM = true; static constexpr int NST = 16; bf16_t* C; const float* colscale; int ldc; float s0; int s0_pn; float s1;
    __device__ __forceinline__ void operator()(const Acc& acc, const Unit& u, int wr, int wc, int fr, int fq) const {
        const int row0 = u.pm * BM + wr * 64 + fr, col0 = u.pn * BM + wc * 32 + 8 * fq;
        const float sc = (u.pn < s0_pn) ? s0 : s1;
        f32x4 cs[2][2];
#pragma unroll
        for (int bj = 0; bj < 2; ++bj)
#pragma unroll
            for (int n = 0; n < 2; ++n) cs[bj][n] = colscale ? *(const f32x4*)(colscale + col0 + bj * HALF + 4 * n) * sc : (f32x4){sc, sc, sc, sc};
#pragma unroll
        for (int ai = 0; ai < 2; ++ai)
#pragma unroll
            for (int m = 0; m < 4; ++m) { bf16_t* rowp = C + (size_t)(row0 + ai * HALF + m * 16) * ldc + col0;
#pragma unroll
                for (int bj = 0; bj < 2; ++bj) ST16(rowp + bj * HALF, pack8(acc[ai][bj][m][0] * cs[bj][0], acc[ai][bj][m][1] * cs[bj][1])); }
    }
};
struct EpHgrnIn { static constexpr bool PERM = true; static constexpr int NST = 16; bf16_t* C; const float* lb;
    __device__ __forceinline__ void operator()(const Acc& acc, const Unit& u, int wr, int wc, int fr, int fq) const {
        const int row0 = u.pm * BM + wr * 64 + fr, col0 = u.pn * BM + wc * 32 + 8 * fq, kind = u.pn >> 2;
        f32x4 om[2][2];
#pragma unroll
        for (int bj = 0; bj < 2; ++bj)
#pragma unroll
            for (int n = 0; n < 2; ++n) om[bj][n] = (kind == 1) ? (1.f - *(const f32x4*)(lb + (col0 - 1024) + bj * HALF + 4 * n)) : (f32x4){0.f, 0.f, 0.f, 0.f};
#pragma unroll
        for (int ai = 0; ai < 2; ++ai)
#pragma unroll
            for (int m = 0; m < 4; ++m) { bf16_t* rowp = C + (size_t)(row0 + ai * HALF + m * 16) * 4096 + col0;
#pragma unroll
                for (int bj = 0; bj < 2; ++bj) { f32x4 v0 = acc[ai][bj][m][0] * 0.03125f, v1 = acc[ai][bj][m][1] * 0.03125f;
                    if (kind == 0 || kind == 3) { v0 = silu4(v0); v1 = silu4(v1); }
                    else if (kind == 1) { f32x4 a, b; a[0] = sigm(-v0[0]); a[1] = sigm(-v0[1]); a[2] = sigm(-v0[2]); a[3] = sigm(-v0[3]); b[0] = sigm(-v1[0]); b[1] = sigm(-v1[1]); b[2] = sigm(-v1[2]); b[3] = sigm(-v1[3]);
                        v0 = a * om[bj][0]; v1 = b * om[bj][1]; }
                    ST16(rowp + bj * HALF, pack8(v0, v1)); } }
    }
};
struct EpConvIn { static constexpr bool PERM = true; static constexpr int NST = 8; bf16_t* Bg; bf16_t* CU;
    __device__ __forceinline__ void operator()(const Acc& acc, const Unit& u, int wr, int wc, int fr, int fq) const {
        const int row0 = u.pm * BM + wr * 64 + fr;
        if (u.pn < 4) {
            const int col0 = u.pn * BM + wc * 32 + 8 * fq;
#pragma unroll
            for (int ai = 0; ai < 2; ++ai)
#pragma unroll
                for (int m = 0; m < 4; ++m) { bf16_t* rowp = Bg + (size_t)(row0 + ai * HALF + m * 16) * D + col0;
#pragma unroll
                    for (int bj = 0; bj < 2; ++bj) ST16(rowp + bj * HALF, pack8(acc[ai][bj][m][0] * 0.03125f, acc[ai][bj][m][1] * 0.03125f)); }
        } else {
            const int col0 = (u.pn - 4) * HALF + wc * 32 + 8 * fq;
#pragma unroll
            for (int ai = 0; ai < 2; ++ai)
#pragma unroll
                for (int m = 0; m < 4; ++m) ST16(CU + (size_t)(row0 + ai * HALF + m * 16) * D + col0, pack8(acc[ai][0][m][0] * acc[ai][1][m][0] * (1.f / 1024.f), acc[ai][0][m][1] * acc[ai][1][m][1] * (1.f / 1024.f)));
        }
    }
};
struct EpSwiGlu { static constexpr bool PERM = true; static constexpr int NST = 4; unsigned char* ACT;
    __device__ __forceinline__ void operator()(const Acc& acc, const Unit& u, int wr, int wc, int fr, int fq) const {
        const int row0 = u.pm * BM + wr * 64 + fr + (fq & 1) * 16, col0 = u.pn * HALF + wc * 32 + 8 * (fq & 2);
#pragma unroll
        for (int ai = 0; ai < 2; ++ai)
#pragma unroll
            for (int mp = 0; mp < 2; ++mp) {
                u32x2 w[2];
#pragma unroll
                for (int q = 0; q < 2; ++q) { const int m = 2 * mp + q;
                    const f32x4 v0 = silu4(acc[ai][0][m][0] * 0.03125f) * acc[ai][1][m][0] * 0.25f, v1 = silu4(acc[ai][0][m][1] * 0.03125f) * acc[ai][1][m][1] * 0.25f;
                    w[q].x = pk_fp8x4(v0[0], v0[1], v0[2], v0[3]); w[q].y = pk_fp8x4(v1[0], v1[1], v1[2], v1[3]); }
                const auto rx = __builtin_amdgcn_permlane16_swap(w[0].x, w[1].x, false, false), ry = __builtin_amdgcn_permlane16_swap(w[0].y, w[1].y, false, false);
                u32x4 o; o.x = rx[0]; o.y = ry[0]; o.z = rx[1]; o.w = ry[1];
                *(u32x4*)(ACT + (size_t)(row0 + ai * HALF + mp * 32) * FF + col0) = o; }
    }
};
struct EpY8 { static constexpr bool PERM = true; static constexpr int NST = 8; unsigned char* Y; const LAS unsigned* rowtab;
    __device__ __forceinline__ void operator()(const Acc& acc, const Unit& u, int wr, int wc, int fr, int fq) const {
        const int col0 = u.pn * BM + wc * 32 + 8 * (fq & 2) + (fq & 1) * HALF;
        unsigned ro[2][4];
#pragma unroll
        for (int ai = 0; ai < 2; ++ai)
#pragma unroll
            for (int m = 0; m < 4; ++m) ro[ai][m] = rowtab[u.ui * 256 + ai * HALF + wr * 64 + m * 16 + fr];
#pragma unroll
        for (int ai = 0; ai < 2; ++ai)
#pragma unroll
            for (int m = 0; m < 4; ++m) {
                u32x2 w[2];
#pragma unroll
                for (int bj = 0; bj < 2; ++bj) { const f32x4 v0 = acc[ai][bj][m][0] * 0.03125f, v1 = acc[ai][bj][m][1] * 0.03125f;
                    w[bj].x = pk_fp8x4(v0[0], v0[1], v0[2], v0[3]); w[bj].y = pk_fp8x4(v1[0], v1[1], v1[2], v1[3]); }
                const auto rx = __builtin_amdgcn_permlane16_swap(w[0].x, w[1].x, false, false), ry = __builtin_amdgcn_permlane16_swap(w[0].y, w[1].y, false, false);
                u32x4 o; o.x = rx[0]; o.y = ry[0]; o.z = rx[1]; o.w = ry[1];
                *(u32x4*)(Y + (size_t)ro[ai][m] + col0) = o; }
    }
};
struct EpResid { static constexpr bool PERM = true; static constexpr int NST = 16; const bf16_t* X; const float* g1; bf16_t* Xo; float s; int pad_;
    __device__ __forceinline__ void operator()(const Acc& acc, const Unit& u, int wr, int wc, int fr, int fq) const {
        const int row0 = u.pm * BM + wr * 64 + fr, col0 = u.pn * BM + wc * 32 + 8 * fq;
        const float* gb = g1 + (size_t)(u.pm >> 4) * 6 * D;
        f32x4 gv[2][2];
#pragma unroll
        for (int bj = 0; bj < 2; ++bj)
#pragma unroll
            for (int n = 0; n < 2; ++n) gv[bj][n] = *(const f32x4*)(gb + col0 + bj * HALF + 4 * n) * s;
        u32x4 xa[3][2];
#define EPR_LOAD(S, Q) do { const size_t rn = (size_t)(row0 + ((Q) >> 2) * HALF + ((Q) & 3) * 16) * D + col0; xa[S][0] = *(const u32x4*)(X + rn); xa[S][1] = *(const u32x4*)(X + rn + HALF); } while (0)
#pragma unroll
        for (int q = 0; q < 3; ++q) EPR_LOAD(q, q);
#pragma unroll
        for (int q = 0; q < 8; ++q) {
            const u32x4 xc[2] = {xa[q % 3][0], xa[q % 3][1]};
            if (q + 3 < 8) EPR_LOAD(q % 3, q + 3);
            const int ai = q >> 2, m = q & 3;
            const size_t ro = (size_t)(row0 + ai * HALF + m * 16) * D + col0;
#pragma unroll
            for (int bj = 0; bj < 2; ++bj) { const u32x4 xq = xc[bj];
                f32x4 x0 = {__uint_as_float(xq.x << 16), __uint_as_float(xq.x & 0xffff0000u), __uint_as_float(xq.y << 16), __uint_as_float(xq.y & 0xffff0000u)};
                f32x4 x1 = {__uint_as_float(xq.z << 16), __uint_as_float(xq.z & 0xffff0000u), __uint_as_float(xq.w << 16), __uint_as_float(xq.w & 0xffff0000u)};
                ST16(Xo + ro + bj * HALF, pack8(x0 + gv[bj][0] * acc[ai][bj][m][0], x1 + gv[bj][1] * acc[ai][bj][m][1])); }
            asm volatile("" ::: "memory");
        }
#undef EPR_LOAD
    }
};

typedef int i32x4v __attribute__((ext_vector_type(4)));
typedef int i32x8v __attribute__((ext_vector_type(8)));
template <class P_> __device__ __forceinline__ int prob_sa(const P_& S) { if constexpr (P_::esz == 1) return S.sa; else return 127; }
template <class P_> __device__ __forceinline__ int prob_sb(const P_& S) { if constexpr (P_::esz == 1) return S.sb; else return 127; }

__device__ __forceinline__ void glds16s(const void* sbase, unsigned voff, unsigned lds_dst) {
    unsigned keep;
    asm volatile("s_mov_b32 %0, m0\n\ts_mov_b32 m0, %3\n\ts_nop 0\n\tglobal_load_lds_dwordx4 %1, %2\n\ts_mov_b32 m0, %0"
                 : "=&s"(keep) : "v"(voff), "s"(sbase), "s"(lds_dst) : "memory");
}
__device__ __forceinline__ const char* uniform_ptr(const char* p) {
    const unsigned long long v = (unsigned long long)p;
    const unsigned lo = __builtin_amdgcn_readfirstlane((unsigned)v), hi = __builtin_amdgcn_readfirstlane((unsigned)(v >> 32));
    return (const char*)(((unsigned long long)hi << 32) | lo);
}

template <class Epi, class Prob>
__device__ __forceinline__ void gemm_phase(LAS unsigned char* lds, const Prob& S, const Epi& E, const int K) {
    int tid_ = threadIdx.x; asm volatile("" : "+v"(tid_));
    const int tid = tid_, wid = __builtin_amdgcn_readfirstlane(tid >> 6), lane = tid & 63, wr = wid >> 2, wc = wid & 3, fr = lane & 15, fq = lane >> 4;
    const int nt = K * Prob::esz / (BK * 2);
    int R[2], C[2]; unsigned voffB[2];
#pragma unroll
    for (int i = 0; i < 2; ++i) { stage_rc(tid * 16 + i * 8192, R[i], C[i]); const int Rb = Epi::PERM ? ((R[i] & ~31) + perm32(R[i] & 31)) : R[i]; voffB[i] = (unsigned)(Rb * S.ldb * Prob::esz + 2 * C[i]); }
    const size_t kstep = (size_t)(BK * 2);
    const int sclA = prob_sa(S), sclB = prob_sb(S); (void)sclA; (void)sclB;
    const size_t hstepB = (size_t)HALF * S.ldb * Prob::esz;
    const unsigned ldsw = (unsigned)wid * 1024u;
    const unsigned ldsbase = __builtin_amdgcn_readfirstlane((unsigned)(size_t)lds);
    const int aoff = lds_byte(wr * 64 + fr, fq * 8), boff = lds_byte(wc * 32 + fr, fq * 8);
#define PG8_SA(b, h) (((b) * 2 + (h)) * HTB)
#define PG8_SB(b, h) ((4 + (b) * 2 + (h)) * HTB)
#define PG8_STAGE(bufoff, gbase, voff) do { _Pragma("unroll") for (int _i = 0; _i < 2; ++_i) glds16s((gbase), (voff)[_i], ldsbase + (unsigned)(bufoff) + ldsw + (unsigned)(_i * 8192)); } while (0)
#define PG8_LDA(dst, b, h) do { if constexpr (Prob::esz == 2) { _Pragma("unroll") for (int m = 0; m < 4; ++m) _Pragma("unroll") for (int k = 0; k < 2; ++k) dst[m][k] = *(const LAS bf16x8*)(lds + PG8_SA(b, h) + aoff + m * 2048 + k * 1024); } \
        else { _Pragma("unroll") for (int m = 0; m < 4; ++m) { const i32x4v lo_ = *(const LAS i32x4v*)(lds + PG8_SA(b, h) + aoff + m * 2048), hi_ = *(const LAS i32x4v*)(lds + PG8_SA(b, h) + aoff + m * 2048 + 1024); dst##8[m] = __builtin_shufflevector(lo_, hi_, 0, 1, 2, 3, 4, 5, 6, 7); } } } while (0)
#define PG8_LDB(dst, b, h) do { if constexpr (Prob::esz == 2) { _Pragma("unroll") for (int n = 0; n < 2; ++n) _Pragma("unroll") for (int k = 0; k < 2; ++k) dst[n][k] = *(const LAS bf16x8*)(lds + PG8_SB(b, h) + boff + n * 2048 + k * 1024); } \
        else { _Pragma("unroll") for (int n = 0; n < 2; ++n) { const i32x4v lo_ = *(const LAS i32x4v*)(lds + PG8_SB(b, h) + boff + n * 2048), hi_ = *(const LAS i32x4v*)(lds + PG8_SB(b, h) + boff + n * 2048 + 1024); dst##8[n] = __builtin_shufflevector(lo_, hi_, 0, 1, 2, 3, 4, 5, 6, 7); } } } while (0)
#define PG8_MMA(ai, bj, At, Bt) do { __builtin_amdgcn_s_setprio(1); _Pragma("unroll") for (int m = 0; m < 4; ++m) _Pragma("unroll") for (int n = 0; n < 2; ++n) { \
        if constexpr (Prob::esz == 2) { _Pragma("unroll") for (int k = 0; k < 2; ++k) acc[ai][bj][m][n] = __builtin_amdgcn_mfma_f32_16x16x32_bf16(Bt[n][k], At[m][k], acc[ai][bj][m][n], 0, 0, 0); } \
        else asm volatile("v_mfma_f32_16x16x128_f8f6f4 %0, %1, %2, %0" : "+v"(acc[ai][bj][m][n]) : "v"(Bt##8[n]), "v"(At##8[m])); } \
        __builtin_amdgcn_s_setprio(0); } while (0)
#define PG8_WAIT_V(n) asm volatile("s_waitcnt vmcnt(" #n ")" ::: "memory")
#define PG8_WAIT_VF() do { if (fresh) asm volatile("s_waitcnt vmcnt(%0)" :: "n"(Epi::NST + 8) : "memory"); else asm volatile("s_waitcnt vmcnt(8)" ::: "memory"); } while (0)
#define PG8_WAIT_L(n) asm volatile("s_waitcnt lgkmcnt(" #n ")" ::: "memory")
#define PG8_BAR __builtin_amdgcn_s_barrier()
#define PG8_SCHED __builtin_amdgcn_sched_barrier(0)
    Unit cur, nxt; int ui = 0;
    if (!S.next(0, cur)) return;
    Acc acc;
#pragma unroll
    for (int a = 0; a < 2; ++a)
#pragma unroll
        for (int b = 0; b < 2; ++b)
#pragma unroll
            for (int m = 0; m < 4; ++m)
#pragma unroll
                for (int n = 0; n < 2; ++n) acc[a][b][m][n] = (f32x4){0.f, 0.f, 0.f, 0.f};
    bf16x8 At[4][2], B0[2][2], B1[2][2];
    i32x8v At8[4], B08[2], B18[2];
    (void)At; (void)B0; (void)B1; (void)At8; (void)B08; (void)B18;
    unsigned offA[2][2], noffA[2][2];
    S.a_off(cur, R, C, offA);
    const char* const Ab = uniform_ptr(S.a_base());
    const char* cB = uniform_ptr(S.b_base(cur));
    PG8_STAGE(PG8_SB(0, 0), cB, voffB); PG8_STAGE(PG8_SB(0, 1), cB + hstepB, voffB); PG8_STAGE(PG8_SA(0, 0), Ab, offA[0]); PG8_STAGE(PG8_SA(0, 1), Ab, offA[1]);
    if (wr == 1) PG8_BAR;
    PG8_WAIT_V(2); PG8_BAR;
    PG8_STAGE(PG8_SB(1, 0), cB + kstep, voffB); PG8_STAGE(PG8_SA(1, 0), Ab + kstep, offA[0]); PG8_STAGE(PG8_SB(1, 1), cB + hstepB + kstep, voffB);
    PG8_WAIT_V(6); PG8_BAR;
    for (;;) {
        const bool has_next = S.next(ui + 1, nxt);
        const char* nB = cB;
        if (has_next) { S.a_off(nxt, R, C, noffA); nB = uniform_ptr(S.b_base(nxt)); }
        else {
#pragma unroll
            for (int h = 0; h < 2; ++h)
#pragma unroll
                for (int i = 0; i < 2; ++i) noffA[h][i] = offA[h][i];
        }
#pragma unroll 1
        for (int t = 0; t < nt; t += 2) {
            const bool last = (t == nt - 2);
            const char* a1 = Ab + (size_t)(t + 1) * kstep;
            const char* a2 = last ? Ab : Ab + (size_t)(t + 2) * kstep; const char* b2 = last ? nB : cB + (size_t)(t + 2) * kstep;
            const char* a3 = a2 + kstep; const char* b3 = b2 + kstep;
            unsigned o2[2][2];
#pragma unroll
            for (int h = 0; h < 2; ++h)
#pragma unroll
                for (int i = 0; i < 2; ++i) o2[h][i] = last ? noffA[h][i] : offA[h][i];
            const bool fresh = (t == 0) && (ui > 0);
            PG8_LDB(B0, 0, 0); PG8_LDB(B1, 0, 1); PG8_SCHED; PG8_LDA(At, 0, 0); if (!fresh) PG8_STAGE(PG8_SA(1, 1), a1, offA[1]);
            PG8_WAIT_VF(); PG8_WAIT_L(0); PG8_BAR; PG8_MMA(0, 0, At, B0); PG8_MMA(0, 1, At, B1); PG8_BAR; PG8_SCHED;
            PG8_LDA(At, 0, 1); PG8_STAGE(PG8_SB(0, 0), b2, voffB); PG8_STAGE(PG8_SB(0, 1), b2 + hstepB, voffB); PG8_STAGE(PG8_SA(0, 0), a2, o2[0]);
            PG8_WAIT_VF(); PG8_WAIT_L(0); PG8_BAR; PG8_MMA(1, 0, At, B0); PG8_MMA(1, 1, At, B1); PG8_BAR; PG8_SCHED;
            PG8_LDB(B0, 1, 0); PG8_LDB(B1, 1, 1); PG8_SCHED; PG8_LDA(At, 1, 0); PG8_STAGE(PG8_SA(0, 1), a2, o2[1]);
            PG8_WAIT_VF(); PG8_WAIT_L(0); PG8_BAR; PG8_MMA(0, 0, At, B0); PG8_MMA(0, 1, At, B1); PG8_BAR; PG8_SCHED;
            PG8_LDA(At, 1, 1); PG8_STAGE(PG8_SB(1, 0), b3, voffB); PG8_STAGE(PG8_SB(1, 1), b3 + hstepB, voffB); PG8_STAGE(PG8_SA(1, 0), a3, o2[0]);
            PG8_WAIT_V(8); PG8_WAIT_L(0); PG8_BAR; PG8_MMA(1, 0, At, B0); PG8_MMA(1, 1, At, B1); PG8_BAR; PG8_SCHED;
        }
        if (has_next) PG8_STAGE(PG8_SA(1, 1), Ab + kstep, noffA[1]);
        if (wr == 0) PG8_BAR;
        if constexpr (Prob::esz == 1) asm volatile("s_nop 15\n\ts_nop 15" ::: "memory");
        E(acc, cur, wr, wc, fr, fq);
        if (!has_next) break;
#pragma unroll
        for (int a = 0; a < 2; ++a)
#pragma unroll
            for (int b = 0; b < 2; ++b)
#pragma unroll
                for (int m = 0; m < 4; ++m)
#pragma unroll
                    for (int n = 0; n < 2; ++n) acc[a][b][m][n] = (f32x4){0.f, 0.f, 0.f, 0.f};
        cur = nxt; cB = nB; ++ui;
#pragma unroll
        for (int h = 0; h < 2; ++h)
#pragma unroll
            for (int i = 0; i < 2; ++i) offA[h][i] = noffA[h][i];
        if (wr == 1) PG8_BAR;
    }
    PG8_WAIT_V(0);
    PG8_BAR;
#undef PG8_SA
#undef PG8_SB
#undef PG8_STAGE
#undef PG8_LDA
#undef PG8_LDB
#undef PG8_MMA
#undef PG8_WAIT_V
#undef PG8_WAIT_VF
#undef PG8_WAIT_L
#undef PG8_BAR
#undef PG8_SCHED
}
}

typedef float f32x16 __attribute__((ext_vector_type(16)));
typedef short s16x4 __attribute__((ext_vector_type(4)));
typedef __bf16 bf16x2_t __attribute__((ext_vector_type(2)));
__device__ __forceinline__ unsigned cvtpk(float lo, float hi) { f32x2_t v = {lo, hi}; bf16x2_t b = __builtin_convertvector(v, bf16x2_t); return __builtin_bit_cast(unsigned, b); }
__device__ __forceinline__ int crow(int i, int h) { return (i & 3) + 8 * (i >> 2) + 4 * h; }
__device__ __forceinline__ bf16x8 pack_step(const f32x16& x, int s) {
    u32x4 w; w.x = cvtpk(x[8 * s + 0], x[8 * s + 1]); w.y = cvtpk(x[8 * s + 2], x[8 * s + 3]); w.z = cvtpk(x[8 * s + 4], x[8 * s + 5]); w.w = cvtpk(x[8 * s + 6], x[8 * s + 7]);
    return __builtin_bit_cast(bf16x8, w);
}
typedef short swa_v4i16 __attribute__((ext_vector_type(4)));
__device__ __forceinline__ s16x4 swa_vtr(const LAS unsigned char* p) { return __builtin_bit_cast(s16x4, __builtin_amdgcn_ds_read_tr16_b64_v4i16((LAS swa_v4i16*)p)); }
#define MFMA32(a, b, c) __builtin_amdgcn_mfma_f32_32x32x16_bf16((a), (b), (c), 0, 0, 0)

constexpr int SWA_KROW = 144;
constexpr int SWA_VROW = 192;
constexpr int SWA_VOFF = 256 * SWA_KROW;

__device__ __forceinline__ void phase_swa(const P& p, int bid, int nblk, LAS unsigned char* lds) {
    const int tid = otid(), wave = __builtin_amdgcn_readfirstlane(tid >> 6), lane = tid & 63, r = lane & 31, h = lane >> 5;
    const bf16_t* QKV = (const bf16_t*)(p.ws + WS_U);
    unsigned char* Z = p.ws + WS_Z;
    LAS unsigned char* Ks = lds;
    LAS unsigned char* Vs = lds + SWA_VOFF;
    constexpr float LOG2E = 1.4426950408889634f;
    const int upb = (NB * 4 * 32) / nblk;
    u32x4 kst[4], vst[4]; bf16x8 qfn[4];
#define SWA_STAGE_LOAD(ID) do { const int id_ = (ID), n_ = id_ & 31, hk_ = (id_ >> 5) & 3, b_ = id_ >> 7; const int kb0_ = (n_ == 0) ? 0 : (n_ - 1) * 128; \
        _Pragma("unroll") for (int q = 0; q < 4; ++q) { const int pc = tid + q * NT, kv = pc >> 3, c8 = pc & 7; \
            const size_t row = (size_t)b_ * SEQ + (kv < 128 ? kb0_ + kv : n_ * 128 + kv - 128); \
            kst[q] = *(const u32x4*)(QKV + row * 1536 + 1024 + hk_ * 64 + c8 * 8); vst[q] = *(const u32x4*)(QKV + row * 1536 + 1280 + hk_ * 64 + c8 * 8); } } while (0)
#define SWA_Q_LOAD(ID, QT) do { const int id_ = (ID), n_ = id_ & 31, hk_ = (id_ >> 5) & 3, b_ = id_ >> 7; const int a_ = (wave & 1) * 2 + (QT); \
        const size_t qrow_ = (size_t)b_ * SEQ + n_ * 128 + a_ * 32 + r; const int hq_ = hk_ * 4 + (wave >> 1); \
        _Pragma("unroll") for (int s = 0; s < 4; ++s) qfn[s] = *(const bf16x8*)(QKV + qrow_ * 1536 + hq_ * 64 + s * 16 + h * 8); } while (0)
    SWA_STAGE_LOAD(bid * upb); SWA_Q_LOAD(bid * upb, 0);
    for (int ui = 0; ui < upb; ++ui) {
        const int id = bid * upb + ui, n = id & 31, hk = (id >> 5) & 3, b = id >> 7;
#pragma unroll
        for (int q = 0; q < 4; ++q) {
            const int pc = tid + q * NT, kv = pc >> 3, c8 = pc & 7;
            const u32x4 kq = kst[q], vq = vst[q];
            *(LAS u32x4*)(Ks + kv * SWA_KROW + c8 * 16) = kq;
            *(LAS u32x4*)(Vs + kv * SWA_VROW + c8 * 16) = vq;
        }
        __syncthreads();
        const int hq = hk * 4 + (wave >> 1);
        const float sink = p.swa_sinks[hq];
#pragma unroll 1
        for (int qt = 0; qt < 2; ++qt) {
            const int a = (wave & 1) * 2 + qt;
            const size_t qrow = (size_t)b * SEQ + n * 128 + a * 32 + r;
            bf16x8 qf[4];
#pragma unroll
            for (int s = 0; s < 4; ++s) qf[s] = qfn[s];
            if (qt == 0) SWA_Q_LOAD(id, 1);
            else if (ui + 1 < upb) { SWA_STAGE_LOAD(id + 1); SWA_Q_LOAD(id + 1, 0); }
            f32x16 st[5];
            bf16x8 kfr[2][4];
#pragma unroll
            for (int s = 0; s < 4; ++s) kfr[0][s] = *(const LAS bf16x8*)(Ks + (a * 32 + r) * SWA_KROW + h * 16 + s * 32);
#pragma unroll
            for (int dl = 0; dl < 5; ++dl) {
#pragma unroll
                for (int i = 0; i < 16; ++i) st[dl][i] = 0.f;
                if (dl + 1 < 5) {
                    const LAS unsigned char* kp = Ks + ((a + dl + 1) * 32 + r) * SWA_KROW + h * 16;
#pragma unroll
                    for (int s = 0; s < 4; ++s) kfr[(dl + 1) & 1][s] = *(const LAS bf16x8*)(kp + s * 32);
                }
#pragma unroll
                for (int s = 0; s < 4; ++s) st[dl] = MFMA32(kfr[dl & 1][s], qf[s], st[dl]);
                __builtin_amdgcn_sched_barrier(0);
            }
#pragma unroll
            for (int i = 0; i < 16; ++i) { const int c = crow(i, h); if (!(c > r)) st[0][i] = -INFINITY; if (!(c <= r)) st[4][i] = -INFINITY; }
            if (n == 0) {
#pragma unroll
                for (int dl = 0; dl < 5; ++dl) if (a + dl < 4) {
#pragma unroll
                    for (int i = 0; i < 16; ++i) st[dl][i] = -INFINITY; }
            }
            float m = sink;
#pragma unroll
            for (int dl = 0; dl < 5; ++dl)
#pragma unroll
                for (int i = 0; i < 16; ++i) m = fmaxf(m, st[dl][i]);
            m = fmaxf(m, __shfl_xor(m, 32));
            const float mb = m * LOG2E;
            float l = 0.f;
#define SWA_EXP(DL) do { _Pragma("unroll") for (int i = 0; i < 16; ++i) { const float e = __builtin_amdgcn_exp2f(st[DL][i] * LOG2E - mb); st[DL][i] = e; l += e; } } while (0)
            SWA_EXP(0);
            const LAS unsigned char* vtb = Vs + (4 * h + ((lane & 15) >> 2)) * SWA_VROW + (((lane >> 4) & 1) * 16 + (lane & 3) * 4) * 2;
            f32x16 o[2];
#pragma unroll
            for (int dt = 0; dt < 2; ++dt)
#pragma unroll
                for (int i = 0; i < 16; ++i) o[dt][i] = 0.f;
#pragma unroll
            for (int dl = 0; dl < 5; ++dl) {
#pragma unroll
                for (int s = 0; s < 2; ++s) {
                    const bf16x8 pf = pack_step(st[dl], s);
#pragma unroll
                    for (int dt = 0; dt < 2; ++dt) {
                        const LAS unsigned char* vp = vtb + ((a + dl) * 32 + 16 * s) * SWA_VROW + dt * 64;
                        const s16x4 lo = swa_vtr(vp), hi = swa_vtr(vp + 8 * SWA_VROW);
                        const bf16x8 vf = __builtin_shufflevector(lo, hi, 0, 1, 2, 3, 4, 5, 6, 7);
                        o[dt] = MFMA32(vf, pf, o[dt]);
                    }
                }
                if (dl + 1 < 5) SWA_EXP(dl + 1);
                if (dl == 1 || dl == 3) __builtin_amdgcn_sched_barrier(0);
            }
#undef SWA_EXP
            l += __shfl_xor(l, 32);
            l += __builtin_amdgcn_exp2f(sink * LOG2E - mb);
            const float inv = 8.f / l;
            unsigned char* zp = Z + qrow * D + hq * 64 + 4 * h;
#pragma unroll
            for (int dt = 0; dt < 2; ++dt)
#pragma unroll
                for (int g = 0; g < 4; ++g) *(unsigned*)(zp + 32 * dt + 8 * g) = pk8x4(o[dt][4 * g] * inv, o[dt][4 * g + 1] * inv, o[dt][4 * g + 2] * inv, o[dt][4 * g + 3] * inv);
        }
        __syncthreads();
    }
#undef SWA_STAGE_LOAD
#undef SWA_Q_LOAD
}

constexpr int HG_QT = 0, HG_KT = 17408, HG_KTT = 34816, HG_VT = 53248, HG_TOT = 57856, HG_VEC = 61952, HG_PO = 63488, HG_POA = 96256;
constexpr int HG_P = 272, HG_PT = 144;
#define HG_LBAR() do { asm volatile("s_waitcnt lgkmcnt(0)" ::: "memory"); __builtin_amdgcn_s_barrier(); asm volatile("" ::: "memory"); } while (0)

__device__ __forceinline__ void phase_hgrn(const P& p, int bid, int nblk, LAS unsigned char* lds) {
    const int tid = otid(), wave = __builtin_amdgcn_readfirstlane(tid >> 6), lane = tid & 63, r = lane & 31, h = lane >> 5;
    const bf16_t* U1 = (const bf16_t*)(p.ws + WS_U);
    bf16_t* O = (bf16_t*)(p.ws + WS_O);
    for (int unit = bid; unit < NB * 8 * 4; unit += nblk) {
        const int vs = unit & 3, hh = (unit >> 2) & 7, b = unit >> 5;
        f32x16 S;
#pragma unroll
        for (int i = 0; i < 16; ++i) S[i] = 0.f;
        const bf16_t* qbase = U1 + ((size_t)b * SEQ + wave * 8) * 4096 + hh * 128 + 2 * lane;
        const bf16_t* vbase = U1 + ((size_t)b * SEQ + (tid >> 3)) * 4096 + 2048 + hh * 128 + vs * 32 + (tid & 7) * 4;
        unsigned qraw[8], kraw[8], qnx[8], knx[8]; u32x2 vraw, vnx;
#pragma unroll
        for (int i = 0; i < 8; ++i) { qraw[i] = *(const unsigned*)(qbase + (size_t)i * 4096); kraw[i] = *(const unsigned*)(qbase + (size_t)i * 4096 + 1024); }
        vraw = *(const u32x2*)vbase;
        asm volatile("" :: "v"(qraw[0]), "v"(qraw[1]), "v"(qraw[2]), "v"(qraw[3]), "v"(qraw[4]), "v"(qraw[5]), "v"(qraw[6]), "v"(qraw[7]), "v"(kraw[0]), "v"(kraw[1]), "v"(kraw[2]), "v"(kraw[3]), "v"(kraw[4]), "v"(kraw[5]), "v"(kraw[6]), "v"(kraw[7]), "v"(vraw));
#pragma unroll 1
        for (int c = 0; c < SEQ / 64; ++c) {
            {
                const int cn = (c + 1 < SEQ / 64) ? c + 1 : SEQ / 64 - 1;
                const size_t adv = (size_t)cn * 64 * 4096;
#pragma unroll
                for (int i = 0; i < 8; ++i) { qnx[i] = *(const unsigned*)(qbase + adv + (size_t)i * 4096); knx[i] = *(const unsigned*)(qbase + adv + (size_t)i * 4096 + 1024); }
                vnx = *(const u32x2*)(vbase + adv);
                asm volatile("" ::: "memory");
            }
            float q0[8], q1[8], k0[8], k1[8], c0[8], c1[8];
            float a0 = 1.f, a1 = 1.f;
#pragma unroll
            for (int i = 0; i < 8; ++i) { q0[i] = bflo(qraw[i]); q1[i] = bfhi(qraw[i]); k0[i] = bflo(kraw[i]); k1[i] = bfhi(kraw[i]);
                a0 *= 1.f - k0[i]; a1 *= 1.f - k1[i]; c0[i] = a0; c1[i] = a1; }
            { f32x2_t tv = {a0, a1}; *(LAS f32x2_t*)(lds + HG_TOT + (wave * 128 + 2 * lane) * 4) = tv; }
            const u32x2 vcur = vraw;
            HG_LBAR();
            float lo0 = 1.f, lo1 = 1.f, hi0 = 1.f, hi1 = 1.f, em0 = 1.f, em1 = 1.f, el0 = 1.f, el1 = 1.f;
#pragma unroll
            for (int w2 = 0; w2 < 8; ++w2) { const f32x2_t tv = *(const LAS f32x2_t*)(lds + HG_TOT + (w2 * 128 + 2 * lane) * 4);
                if (w2 < 4) { em0 *= tv.x; em1 *= tv.y; if (w2 >= wave) { lo0 *= tv.x; lo1 *= tv.y; } }
                else { el0 *= tv.x; el1 *= tv.y; if (w2 < wave) { hi0 *= tv.x; hi1 *= tv.y; } } }
            const float sc0 = (wave >= 4) ? hi0 : __builtin_amdgcn_rcpf(lo0), sc1 = (wave >= 4) ? hi1 : __builtin_amdgcn_rcpf(lo1);
            u32x4 kt0, kt1;
            unsigned ktw0[4], ktw1[4];
#pragma unroll
            for (int i = 0; i < 8; i += 2) {
                const float e00 = c0[i] * sc0, e01 = c1[i] * sc1, e10 = c0[i + 1] * sc0, e11 = c1[i + 1] * sc1;
                const float r00 = __builtin_amdgcn_rcpf(e00), r01 = __builtin_amdgcn_rcpf(e01), r10 = __builtin_amdgcn_rcpf(e10), r11 = __builtin_amdgcn_rcpf(e11);
                const float kk00 = k0[i] * r00, kk01 = k1[i] * r01, kk10 = k0[i + 1] * r10, kk11 = k1[i + 1] * r11;
                const int t = wave * 8 + i;
                *(LAS unsigned*)(lds + HG_QT + t * HG_P + lane * 4) = cvtpk(q0[i] * e00, q1[i] * e01);
                *(LAS unsigned*)(lds + HG_QT + (t + 1) * HG_P + lane * 4) = cvtpk(q0[i + 1] * e10, q1[i + 1] * e11);
                *(LAS unsigned*)(lds + HG_KT + t * HG_P + lane * 4) = cvtpk(kk00, kk01);
                *(LAS unsigned*)(lds + HG_KT + (t + 1) * HG_P + lane * 4) = cvtpk(kk10, kk11);
                ktw0[i >> 1] = cvtpk(kk00, kk10); ktw1[i >> 1] = cvtpk(kk01, kk11);
            }
            kt0.x = ktw0[0]; kt0.y = ktw0[1]; kt0.z = ktw0[2]; kt0.w = ktw0[3]; kt1.x = ktw1[0]; kt1.y = ktw1[1]; kt1.z = ktw1[2]; kt1.w = ktw1[3];
            *(LAS u32x4*)(lds + HG_KTT + (2 * lane) * HG_PT + wave * 16) = kt0;
            *(LAS u32x4*)(lds + HG_KTT + (2 * lane + 1) * HG_PT + wave * 16) = kt1;
            if (wave == 0) {
                f32x2_t em = {em0, em1}, el = {el0, el1}, gg = {em0 * el0, em1 * el1};
                *(LAS f32x2_t*)(lds + HG_VEC + (2 * lane) * 4) = em; *(LAS f32x2_t*)(lds + HG_VEC + 512 + (2 * lane) * 4) = el; *(LAS f32x2_t*)(lds + HG_VEC + 1024 + (2 * lane) * 4) = gg;
            }
            { const int s = tid >> 3, j4 = (tid & 7) * 4; LAS unsigned char* vp = lds + HG_VT + j4 * HG_PT + s * 2;
                *(LAS unsigned short*)(vp) = (unsigned short)(vcur.x & 0xffffu); *(LAS unsigned short*)(vp + HG_PT) = (unsigned short)(vcur.x >> 16);
                *(LAS unsigned short*)(vp + 2 * HG_PT) = (unsigned short)(vcur.y & 0xffffu); *(LAS unsigned short*)(vp + 3 * HG_PT) = (unsigned short)(vcur.y >> 16); }
            HG_LBAR();
            if (wave < 4) {
                const int w = wave;
                f32x4 emv[4], elv[4], gv[4];
#pragma unroll
                for (int g4 = 0; g4 < 4; ++g4) { const int d = 32 * w + 8 * g4 + 4 * h;
                    emv[g4] = *(const LAS f32x4*)(lds + HG_VEC + d * 4); elv[g4] = *(const LAS f32x4*)(lds + HG_VEC + 512 + d * 4); gv[g4] = *(const LAS f32x4*)(lds + HG_VEC + 1024 + d * 4); }
                s16x4 qlo[2][2], qhi[2][2];
#pragma unroll
                for (int tt = 0; tt < 2; ++tt)
#pragma unroll
                    for (int sp = 0; sp < 2; ++sp) { const LAS unsigned char* ap = lds + HG_QT + (32 * tt + r) * HG_P + (32 * w + 16 * sp + 4 * h) * 2;
                        qlo[tt][sp] = *(const LAS s16x4*)ap; qhi[tt][sp] = *(const LAS s16x4*)(ap + 16); }
                bf16x8 akf[4], bvf[4];
#pragma unroll
                for (int ks = 0; ks < 4; ++ks) { akf[ks] = *(const LAS bf16x8*)(lds + HG_KTT + (32 * w + r) * HG_PT + (16 * ks + 8 * h) * 2);
                    bvf[ks] = *(const LAS bf16x8*)(lds + HG_VT + r * HG_PT + (16 * ks + 8 * h) * 2); }
                __builtin_amdgcn_sched_barrier(0);
                f32x16 Sem;
#pragma unroll
                for (int i = 0; i < 16; ++i) Sem[i] = S[i] * emv[i >> 2][i & 3];
                const bf16x8 bS0 = pack_step(Sem, 0), bS1 = pack_step(Sem, 1);
#pragma unroll
                for (int tt = 0; tt < 2; ++tt) {
                    f32x16 op;
#pragma unroll
                    for (int i = 0; i < 16; ++i) op[i] = 0.f;
#pragma unroll
                    for (int sp = 0; sp < 2; ++sp) {
                        const bf16x8 aq = __builtin_shufflevector(qlo[tt][sp], qhi[tt][sp], 0, 1, 2, 3, 4, 5, 6, 7);
                        op = MFMA32(aq, sp == 0 ? bS0 : bS1, op);
                    }
#pragma unroll
                    for (int g4 = 0; g4 < 4; ++g4) { f32x4 v = {op[4 * g4], op[4 * g4 + 1], op[4 * g4 + 2], op[4 * g4 + 3]};
                        *(LAS f32x4*)(lds + HG_PO + ((w * 2 + tt) * 4 + g4) * 1024 + lane * 16) = v; }
                }
                f32x16 dS;
#pragma unroll
                for (int i = 0; i < 16; ++i) dS[i] = 0.f;
#pragma unroll
                for (int ks = 0; ks < 4; ++ks) dS = MFMA32(akf[ks], bvf[ks], dS);
#pragma unroll
                for (int i = 0; i < 16; ++i) S[i] = S[i] * gv[i >> 2][i & 3] + dS[i] * elv[i >> 2][i & 3];
            } else if (wave < 7) {
                const int ss = (wave == 6) ? 1 : 0, tt = (wave == 4) ? 0 : 1;
                f32x16 at;
#pragma unroll
                for (int i = 0; i < 16; ++i) at[i] = 0.f;
                bf16x8 akf[8], bqf[8];
#pragma unroll
                for (int kd = 0; kd < 8; ++kd) { akf[kd] = *(const LAS bf16x8*)(lds + HG_KT + (32 * ss + r) * HG_P + (16 * kd + 8 * h) * 2);
                    bqf[kd] = *(const LAS bf16x8*)(lds + HG_QT + (32 * tt + r) * HG_P + (16 * kd + 8 * h) * 2); }
                s16x4 vlo[2], vhi[2];
#pragma unroll
                for (int sp = 0; sp < 2; ++sp) { const LAS unsigned char* vp = lds + HG_VT + r * HG_PT + (32 * ss + 16 * sp + 4 * h) * 2; vlo[sp] = *(const LAS s16x4*)vp; vhi[sp] = *(const LAS s16x4*)(vp + 16); }
                __builtin_amdgcn_sched_barrier(0);
#pragma unroll
                for (int kd = 0; kd < 8; ++kd) at = MFMA32(akf[kd], bqf[kd], at);
                if (ss == tt) {
#pragma unroll
                    for (int i = 0; i < 16; ++i) if (crow(i, h) > r) at[i] = 0.f;
                }
                f32x16 oi;
#pragma unroll
                for (int i = 0; i < 16; ++i) oi[i] = 0.f;
#pragma unroll
                for (int sp = 0; sp < 2; ++sp) {
                    const bf16x8 pa = pack_step(at, sp);
                    const bf16x8 vb = __builtin_shufflevector(vlo[sp], vhi[sp], 0, 1, 2, 3, 4, 5, 6, 7);
                    oi = MFMA32(pa, vb, oi);
                }
#pragma unroll
                for (int g4 = 0; g4 < 4; ++g4) { f32x4 v = {oi[4 * g4], oi[4 * g4 + 1], oi[4 * g4 + 2], oi[4 * g4 + 3]};
                    *(LAS f32x4*)(lds + HG_POA + ((wave - 4) * 4 + g4) * 1024 + lane * 16) = v; }
            }
            HG_LBAR();
            {
                const int tt = wave >> 2, g4 = wave & 3;
                f32x4 pp[4];
#pragma unroll
                for (int w2 = 0; w2 < 4; ++w2) pp[w2] = *(const LAS f32x4*)(lds + HG_PO + ((w2 * 2 + tt) * 4 + g4) * 1024 + lane * 16);
                const f32x4 pa0 = *(const LAS f32x4*)(lds + HG_POA + (tt * 4 + g4) * 1024 + lane * 16);
                const f32x4 pa1 = *(const LAS f32x4*)(lds + HG_POA + (2 * 4 + g4) * 1024 + lane * 16);
                __builtin_amdgcn_sched_barrier(0);
                const float s1 = tt ? 1.f : 0.f;
                f32x4 sum = ((pp[0] + pp[1]) + (pp[2] + pp[3])) + (pa0 + pa1 * s1);
                bf16_t* op_ = O + ((size_t)b * SEQ + c * 64 + 32 * tt + 8 * g4 + 4 * h) * D + hh * 128 + vs * 32 + r;
#pragma unroll
                for (int e = 0; e < 4; ++e) op_[(size_t)e * D] = (bf16_t)f2bf(sum[e]);
            }
            asm volatile("" ::: "memory");
#pragma unroll
            for (int i = 0; i < 8; ++i) { qraw[i] = qnx[i]; kraw[i] = knx[i]; }
            vraw = vnx;
            asm volatile("" :: "v"(qraw[0]), "v"(qraw[1]), "v"(qraw[2]), "v"(qraw[3]), "v"(qraw[4]), "v"(qraw[5]), "v"(qraw[6]), "v"(qraw[7]), "v"(kraw[0]), "v"(kraw[1]), "v"(kraw[2]), "v"(kraw[3]), "v"(kraw[4]), "v"(kraw[5]), "v"(kraw[6]), "v"(kraw[7]), "v"(vraw));
        }
        __syncthreads();
    }
}

#define XB_TMO      128
#define XB_XCNT(j)  (256  + 64 * (j))
#define XB_XSUB(j)  (1280 + 64 * (j))
#define XB_XGEN(j)  (2304 + 64 * (j))
#define XB_TOP      3328
#define XB_TOPGEN   3392
#define XCD_BAR_WORDS 3456
#define XB_SPIN_CAP (1u << 18)

__device__ __forceinline__ unsigned xb_ld(unsigned* p)              { return __hip_atomic_load(p, __ATOMIC_RELAXED, __HIP_MEMORY_SCOPE_AGENT); }
__device__ __forceinline__ unsigned xb_add(unsigned* p, unsigned v) { return __hip_atomic_fetch_add(p, v, __ATOMIC_RELAXED, __HIP_MEMORY_SCOPE_AGENT); }
__device__ __forceinline__ unsigned xb_xcc_id() { return (unsigned)__builtin_amdgcn_s_getreg((3 << 11) | 20) & 0xFu; }
#define XB_SPIN(cond, bar) do { unsigned _sp = 0; while (cond) { __builtin_amdgcn_s_sleep(1); \
    if ((++_sp & 255u) == 0u) { if (xb_ld(&(bar)[XB_TMO])) break; if (_sp > XB_SPIN_CAP) { atomicAdd(&(bar)[XB_TMO], 1u); break; } } } } while (0)

struct XcdBarrier {
    unsigned* bar; unsigned x;
    volatile LAS unsigned* st;
};
__device__ __forceinline__ XcdBarrier xcd_barrier_post(unsigned* bar, volatile LAS unsigned* st) {
    XcdBarrier b; b.bar = bar; b.x = xb_xcc_id(); b.st = st;
    if (threadIdx.x == 0) (void)xb_add(&bar[XB_XCNT(b.x)], 1u);
    return b;
}
__device__ __forceinline__ void xcd_barrier_complete(unsigned* bar, unsigned x, unsigned& nloc, unsigned& nx) {
    const unsigned G = gridDim.x * gridDim.y * gridDim.z;
    unsigned sum, cnt, mine, sp = 0u;
    for (;;) {
        sum = 0u; cnt = 0u; mine = 0u;
#pragma unroll
        for (unsigned j = 0; j < 16; ++j) { const unsigned c = xb_ld(&bar[XB_XCNT(j)]); sum += c; cnt += (c > 0u) ? 1u : 0u; mine = (j == x) ? c : mine; }
        if (sum == G) break;
        __builtin_amdgcn_s_sleep(1);
        if ((++sp & 255u) == 0u) { if (xb_ld(&bar[XB_TMO])) break; if (sp > XB_SPIN_CAP) { atomicAdd(&bar[XB_TMO], 1u); break; } }
    }
    nloc = mine > 0u ? mine : 1u; nx = cnt > 0u ? cnt : 1u;
}
__device__ __forceinline__ void xcd_barrier(const XcdBarrier& b) {
    asm volatile("s_waitcnt vmcnt(0)" ::: "memory");
    __syncthreads();
    if (threadIdx.x == 0) {
        unsigned* bar = b.bar;
        __builtin_amdgcn_s_waitcnt(0);
        unsigned nloc = b.st[0], nx = b.st[1];
        if (nloc == 0u) { xcd_barrier_complete(bar, b.x, nloc, nx); b.st[0] = nloc; b.st[1] = nx; }
        const unsigned old = xb_add(&bar[XB_XSUB(b.x)], 1u);
        const unsigned gen = old / nloc;
        if (old + 1u == (gen + 1u) * nloc) {
            __builtin_amdgcn_fence(__ATOMIC_RELEASE, "agent");
            asm volatile("s_waitcnt vmcnt(0)" ::: "memory");
            const unsigned og = xb_add(&bar[XB_TOP], 1u);
            const unsigned tg = og / nx;
            if (og + 1u == (tg + 1u) * nx) xb_add(&bar[XB_TOPGEN], 1u);
            else XB_SPIN(xb_ld(&bar[XB_TOPGEN]) == tg, bar);
            __builtin_amdgcn_fence(__ATOMIC_ACQUIRE, "agent");
            xb_add(&bar[XB_XGEN(b.x)], 1u);
            asm volatile("s_waitcnt vmcnt(0)" ::: "memory");
        } else {
            XB_SPIN(xb_ld(&bar[XB_XGEN(b.x)]) == gen, bar);
            __builtin_amdgcn_fence(__ATOMIC_ACQUIRE, "agent");
            asm volatile("s_waitcnt vmcnt(0)" ::: "memory");
        }
    }
    __syncthreads();
}

__device__ __forceinline__ void cvt_item(const float* W, int ldw, int k0, int n0, bf16_t* WT, int ldt, int drow0, LAS unsigned char* T, int lane) {
    const int kp = lane >> 5, nq = lane & 31;
    const float* src = W + (size_t)(k0 + 2 * kp) * ldw + n0 + 4 * nq;
    const unsigned sw = (unsigned)(nq & 28);
#pragma unroll
    for (int half = 0; half < 2; ++half) {
        f32x4 v[8][2];
#pragma unroll
        for (int s = 0; s < 8; ++s) { const float* q = src + (size_t)(4 * (half * 8 + s)) * ldw; v[s][0] = *(const f32x4*)q; v[s][1] = *(const f32x4*)(q + ldw); }
#pragma unroll
        for (int s = 0; s < 8; ++s) {
            const unsigned pd = (unsigned)(2 * (half * 8 + s) + kp);
            const unsigned col = ((pd ^ sw) << 2);
#pragma unroll
            for (int i = 0; i < 4; ++i) *(LAS unsigned*)(T + (4 * nq + i) * 128 + col) = pk2(v[s][0][i], v[s][1][i]);
        }
    }
    asm volatile("s_waitcnt lgkmcnt(0)" ::: "memory");
    const int c = lane & 7;
#pragma unroll 4
    for (int q = 0; q < 16; ++q) {
        const int n = 8 * q + (lane >> 3);
        const u32x4 o = *(const LAS u32x4*)(T + n * 128 + (((unsigned)(4 * c) ^ (unsigned)((n >> 2) & 28)) << 2));
        *(u32x4*)(WT + (size_t)(drow0 + n) * ldt + k0 + 8 * c) = o;
    }
    asm volatile("s_waitcnt lgkmcnt(0)" ::: "memory");
}
__device__ __forceinline__ int dual_row(int n, int half) { return (n >> 7) * 256 + half * 128 + (n & 127); }

__device__ __forceinline__ unsigned pk_fp8x4_(float a, float b, float c, float d) { return pk8x4(a, b, c, d); }
struct CvtSrc { const float* W; unsigned char* WT; int ldw, k0, n0, drow0; };
__device__ __forceinline__ void cvt8_issue(const CvtSrc& s, int qt, int lane, f32x4 (&v)[4][4]) {
    const int kp = lane >> 5, nq = lane & 31;
    const float* ub = s.W + (size_t)(s.k0 + 32 * qt) * s.ldw + s.n0;
    const unsigned lo = (unsigned)(4 * kp * s.ldw + 4 * nq);
#pragma unroll
    for (int st = 0; st < 4; ++st)
#pragma unroll
        for (int rr = 0; rr < 4; ++rr) v[st][rr] = __builtin_nontemporal_load((const f32x4*)(ub + (size_t)(8 * st + rr) * s.ldw + lo));
}
__device__ __forceinline__ void cvt8_pack(int qt, int lane, const f32x4 (&v)[4][4], LAS unsigned char* T, float scale) {
    const int kp = lane >> 5, nq = lane & 31;
    const unsigned sw = (unsigned)(nq & 28);
#pragma unroll
    for (int st = 0; st < 4; ++st) {
        const unsigned pd = (unsigned)(2 * (qt * 4 + st) + kp);
        const unsigned col = ((pd ^ sw) << 2);
#pragma unroll
        for (int i = 0; i < 4; ++i) *(LAS unsigned*)(T + (4 * nq + i) * 128 + col) = pk_fp8x4_(v[st][0][i] * scale, v[st][1][i] * scale, v[st][2][i] * scale, v[st][3][i] * scale);
    }
}
__device__ __forceinline__ void cvt8_flush(const CvtSrc& s, int lane, LAS unsigned char* T) {
    asm volatile("s_waitcnt lgkmcnt(0)" ::: "memory");
    const int c = lane & 7;
#pragma unroll 4
    for (int q = 0; q < 16; ++q) {
        const int n = 8 * q + (lane >> 3);
        const u32x4 o = *(const LAS u32x4*)(T + n * 128 + (((unsigned)(4 * c) ^ (unsigned)((n >> 2) & 28)) << 2));
        *(u32x4*)(s.WT + (size_t)(s.drow0 + n) * 1024 + s.k0 + 16 * c) = o;
    }
    asm volatile("s_waitcnt lgkmcnt(0)" ::: "memory");
}

constexpr int CVPRO = 1;
constexpr int CV_LAYER_ITEMS = 3 * 16 * 64;
constexpr float W8_SCALE = 32.f;
__device__ __forceinline__ CvtSrc moe_item(const P& p, int layer, int it) {
    const int tsr = it >> 10, r = it & 1023, le = layer * NE + (r >> 6), item = r & 63, kb = item >> 3, nb = item & 7;
    CvtSrc s; s.ldw = 1024; s.k0 = kb * 128; s.n0 = nb * 128;
    if (tsr == 0)      { s.W = p.moe_w_gate + (size_t)le * D * FF; s.WT = p.ws + WT_GU + (size_t)le * 2048 * 1024; s.drow0 = dual_row(nb * 128, 0); }
    else if (tsr == 1) { s.W = p.moe_w_up + (size_t)le * D * FF;   s.WT = p.ws + WT_GU + (size_t)le * 2048 * 1024; s.drow0 = dual_row(nb * 128, 1); }
    else               { s.W = p.moe_w_down + (size_t)le * FF * D; s.WT = p.ws + WT_DN + (size_t)le * 1024 * 1024; s.drow0 = nb * 128; }
    return s;
}
constexpr int CV_DENSE8_ITEMS = 64 + 256 + 96 + 192 + 3 * 64;
__device__ __forceinline__ CvtSrc dense8_item(const P& p, int r) {
    CvtSrc s;
    if (r < 64) { const int kb = r >> 3, nb = r & 7; s.W = p.pool_w_in; s.WT = p.ws + WT_POOL_IN; s.ldw = 1024; s.k0 = kb * 128; s.n0 = nb * 128; s.drow0 = nb * 128; return s; } r -= 64;
    if (r < 256) { const int kb = r >> 5, nb = r & 31; s.W = p.hgrn_w_in; s.WT = p.ws + WT_HGRN_IN; s.ldw = 4096; s.k0 = kb * 128; s.n0 = nb * 128; s.drow0 = nb * 128; return s; } r -= 256;
    if (r < 96) { const int kb = r / 12, nb = r % 12; s.W = p.swa_w_in; s.WT = p.ws + WT_SWA_IN; s.ldw = 1536; s.k0 = kb * 128; s.n0 = nb * 128; s.drow0 = nb * 128; return s; } r -= 96;
    if (r >= 192) { r -= 192; const int w = r >> 6, kb = (r >> 3) & 7, nb = r & 7; s.W = w == 0 ? p.hgrn_w_out : (w == 1 ? p.swa_w_out : p.conv_w_out);
        s.WT = p.ws + (w == 0 ? WT_HGRN_OUT : (w == 1 ? WT_SWA_OUT : WT_CONV_OUT)); s.ldw = 1024; s.k0 = kb * 128; s.n0 = nb * 128; s.drow0 = nb * 128; return s; }
    { const int kb = r / 24, nb = r % 24, n0 = nb * 128; s.W = p.conv_w_in; s.WT = p.ws + WT_CONV_IN; s.ldw = 3072; s.k0 = kb * 128; s.n0 = n0;
      s.drow0 = n0 < 1024 ? n0 : (n0 < 2048 ? 1024 + dual_row(n0 - 1024, 0) : 1024 + dual_row(n0 - 2048, 1)); return s; }
}
__device__ __forceinline__ CvtSrc any8_item(const P& p, int layer, int it) { return it < CV_LAYER_ITEMS ? moe_item(p, layer, it) : dense8_item(p, it - CV_LAYER_ITEMS); }
__device__ __forceinline__ void convert_moe(const P& p, int layer, int i0, int i1, int vw, int nvw, LAS unsigned char* T, int lane) {
    int it = __builtin_amdgcn_readfirstlane(i0 + vw);
    if (it >= i1) return;
    f32x4 va[4][4], vb[4][4];
    CvtSrc cur = any8_item(p, layer, it);
    cvt8_issue(cur, 0, lane, va); cvt8_issue(cur, 1, lane, vb);
    for (;;) {
        cvt8_pack(0, lane, va, T, W8_SCALE); cvt8_issue(cur, 2, lane, va);
        cvt8_pack(1, lane, vb, T, W8_SCALE); cvt8_issue(cur, 3, lane, vb);
        const int nx = it + nvw; const bool more = nx < i1;
        const CvtSrc nxt = any8_item(p, layer, more ? nx : it);
        cvt8_pack(2, lane, va, T, W8_SCALE); if (more) cvt8_issue(nxt, 0, lane, va);
        cvt8_pack(3, lane, vb, T, W8_SCALE); if (more) cvt8_issue(nxt, 1, lane, vb);
        cvt8_flush(cur, lane, T);
        if (!more) break;
        cur = nxt; it = nx;
    }
}

__device__ __forceinline__ void phase_convert(const P& p, int bid, int nblk, LAS unsigned char* lds) {
    const int tid = otid(), wave = tid >> 6, lane = tid & 63;
    LAS unsigned char* T = lds + wave * 16384;
    const int gw = bid * NWV + wave, NGW = nblk * NWV;
    unsigned char* ws = p.ws;
    for (int ly = 0; ly < CVPRO; ++ly) convert_moe(p, ly, 0, CV_LAYER_ITEMS + (ly == 0 ? CV_DENSE8_ITEMS : 0), gw, NGW, T, lane);
    constexpr int I_SQ = 128, I_GRP = 32;
    constexpr int NSMALL = I_SQ + I_GRP;
    for (int it = (gw + NGW - (CV_LAYER_ITEMS + CV_DENSE8_ITEMS) % NGW) % NGW; it < NSMALL; it += NGW) {
        int r = it;
        if (r < I_GRP) {
#pragma unroll 4
            for (int q = 0; q < 32; ++q) { const int e4 = r * 2048 + q * 64 + lane, e = e4 * 4, g = e >> 16, d = e & 255; const f32x4 w = *(const f32x4*)(p.pool_w_grp + e) * *(const f32x4*)(p.pool_scale + g * 256 + d);
                u32x2 o; o.x = pk2(w.x, w.y); o.y = pk2(w.z, w.w); *(u32x2*)((bf16_t*)(ws + WT_POOL_GRP) + e) = o; }
            continue; } r -= I_GRP;
        if (r < I_SQ) { cvt_item(p.pool_w_out, D, (r >> 3) * 64, (r & 7) * 128, (bf16_t*)(ws + WT_POOL_OUT), D, (r & 7) * 128, T, lane); continue; } r -= I_SQ;
    }
}

constexpr int LDS_RING = pg8::STAGE_BYTES;
constexpr int LDS_MISC = LDS_RING;
constexpr int LDS_ROWTAB = LDS_RING + 1024;
constexpr int LDS_BYTES = LDS_ROWTAB + 12 * 1024;
constexpr int NPHASE = 31;
constexpr int CV1 = 40, CV2 = 40, CVSPLIT = 1984;

__global__ void __launch_bounds__(NT, 2) mega(P p, int lo, int hi) {
    extern __shared__ __attribute__((aligned(16))) unsigned char lds_raw[];
    LAS unsigned char* lds = (LAS unsigned char*)lds_raw;
    float* ldsf = (float*)lds_raw;
    const int tid = threadIdx.x, bid = blockIdx.x, nblk = gridDim.x;
    unsigned char* ws = p.ws;
    unsigned* ctl = (unsigned*)(ws + WS_CTL);
    const float* mod = (const float*)(ws + WS_MOD);
    const unsigned char* H8 = ws + WS_H; bf16_t* H = (bf16_t*)(ws + WS_H); bf16_t* Z = (bf16_t*)(ws + WS_Z); bf16_t* U = (bf16_t*)(ws + WS_U);
    bf16_t* U2 = (bf16_t*)(ws + WS_U + ((size_t)64 << 20));
    bf16_t* ACT = (bf16_t*)(ws + WS_ACT); bf16_t* Y = (bf16_t*)(ws + WS_Y);
    LAS int* geo = (LAS int*)(lds + LDS_MISC + 16);
    if (tid < 4) ((LAS unsigned*)(lds + LDS_MISC))[tid] = 0u;
    __syncthreads();
    XcdBarrier bar; bar.bar = ctl; bar.x = 0; bar.st = nullptr;
    if (hi - lo > 1) bar = xcd_barrier_post(ctl, (volatile LAS unsigned*)(lds + LDS_MISC));
    int ph = 0;
#define XOUT ((bf16_t*)(ws + WS_XB))
#define CNTL l
#define PH_BEGIN if (lo <= ph && ph < hi) {
#define PH_END if (ph + 1 < hi) xcd_barrier(bar); else __syncthreads(); } ++ph;

    PH_BEGIN  phase_prep(p, bid, nblk, ldsf); __syncthreads(); phase_convert(p, bid, nblk, lds);  PH_END

    for (int l = 0; l < DEPTH; ++l) {
        PH_BEGIN  if (l == 0) { phase_norm<0>(p, l, bid, nblk, ldsf);
                pg8::DenseProb S{(const bf16_t*)(ws + WT_POOL_OUT), (const bf16_t*)(ws + WT_POOL_GRP), D, 256, 256, 4, 4, nblk, bid}; pg8::EpPlain E{(bf16_t*)(ws + WT_POOL_W2), nullptr, D, 1.f, 0, 1.f}; pg8::gemm_phase(lds, S, E, 256); }
            else phase_norm<1>(p, l, bid, nblk, ldsf, -1, XOUT);  PH_END
        const bf16_t* wout; const bf16_t* aout = Z;
        if (l == 0) {
            PH_BEGIN  { pg8::DenseProb8 S{H8, ws + WT_POOL_IN, D, D, M / 256, 4, nblk, bid, 127, 122}; pg8::EpPlain E{U, nullptr, D, 1.f, 0, 0.03125f}; pg8::gemm_phase(lds, S, E, D); }  PH_END
            PH_BEGIN  phase_pool(p, bid, nblk);  PH_END
            wout = (const bf16_t*)(ws + WT_POOL_W2); aout = U2;
        } else if (l == 1) {
            PH_BEGIN  { pg8::DenseProb8 S{H8, ws + WT_HGRN_IN, D, D, M / 256, 16, nblk, bid, 127, 122}; pg8::EpHgrnIn E{U, (const float*)(ws + WS_LB)}; pg8::gemm_phase(lds, S, E, D); }  PH_END
            PH_BEGIN  phase_hgrn(p, bid, nblk, lds);  PH_END
            PH_BEGIN  phase_hgrn_gate(p, bid, nblk);  PH_END
            wout = (const bf16_t*)(ws + WT_HGRN_OUT);
        } else if (l == 2) {
            PH_BEGIN  { pg8::DenseProb8 S{H8, ws + WT_SWA_IN, D, D, M / 256, 6, nblk, bid, 127, 122}; pg8::EpPlain E{U, nullptr, 1536, 0.125f * 0.03125f, 4, 0.03125f}; pg8::gemm_phase(lds, S, E, D); }  PH_END
            PH_BEGIN  phase_swa(p, bid, nblk, lds);  PH_END
            wout = (const bf16_t*)(ws + WT_SWA_OUT);
        } else {
            PH_BEGIN  { pg8::DenseProb8 S{H8, ws + WT_CONV_IN, D, D, M / 256, 12, nblk, bid, 127, 122}; pg8::EpConvIn E{U, U2}; pg8::gemm_phase(lds, S, E, D); }  PH_END
            PH_BEGIN  phase_conv(p, bid, nblk);  PH_END
            wout = (const bf16_t*)(ws + WT_CONV_OUT);
        }
        PH_BEGIN  {
            if (l == 0) { pg8::DenseProb S{aout, wout, D, D, 0, M / 256, 4, nblk, bid}; pg8::EpResid E{(const bf16_t*)(ws + WS_XB), mod + (size_t)l * NB * 6 * D + 2 * D, XOUT, 1.f, 0}; pg8::gemm_phase(lds, S, E, D); }
            else { pg8::DenseProb8 S{(const unsigned char*)aout, (const unsigned char*)wout, D, D, M / 256, 4, nblk, bid, 127, 122};
                pg8::EpResid E{(const bf16_t*)(ws + WS_XB), mod + (size_t)l * NB * 6 * D + 2 * D, XOUT, 1.f / 256.f, 0}; pg8::gemm_phase(lds, S, E, D); } }  PH_END
        PH_BEGIN  phase_norm3(p, l, bid, nblk, ldsf, CNTL);  PH_END
        PH_BEGIN  {
            if (tid < 64) {
                const int c = tid < NE ? (int)__hip_atomic_load(ctl + CW_CNT + (l * 16 + tid) * 64, __ATOMIC_RELAXED, __HIP_MEMORY_SCOPE_AGENT) : 0;
                const int tl = (c + 255) >> 8; int ps = tl;
#pragma unroll
                for (int o = 1; o < 16; o <<= 1) { const int v = __shfl_up(ps, o); if ((tid & 63) >= o) ps += v; }
                if (tid < NE) { geo[tid] = ps - tl; geo[NE + 1 + tid] = c; }
                if (tid == NE - 1) geo[NE] = ps;
            }
            __syncthreads();
            const int ng1 = (l + 1 < DEPTH && l + 1 >= CVPRO) ? nblk - CV1 : nblk;
            if (bid < ng1) {
                pg8::MoeProb S{(const unsigned char*)H, ws + WT_GU + (size_t)l * NE * 2048 * 1024, (size_t)2048 * 1024, (const int*)(ws + WS_RTOK), geo, (const LAS unsigned*)(lds + LDS_ROWTAB), D, D, 8, ng1, bid, 1, 127, 122};
                S.fill_rowtab<0, 12>((LAS unsigned*)(lds + LDS_ROWTAB), tid); __syncthreads();
                pg8::EpSwiGlu E{(unsigned char*)ACT}; pg8::gemm_phase(lds, S, E, D);
            } else convert_moe(p, l + 1, 0, CVSPLIT, (bid - ng1) * NWV + (otid() >> 6), CV1 * NWV, lds + (otid() >> 6) * 16384, otid() & 63); }  PH_END
        PH_BEGIN  {
            if (tid < 64) {
                const int c = tid < NE ? (int)__hip_atomic_load(ctl + CW_CNT + (l * 16 + tid) * 64, __ATOMIC_RELAXED, __HIP_MEMORY_SCOPE_AGENT) : 0;
                const int tl = (c + 255) >> 8; int ps = tl;
#pragma unroll
                for (int o = 1; o < 16; o <<= 1) { const int v = __shfl_up(ps, o); if ((tid & 63) >= o) ps += v; }
                if (tid < NE) { geo[tid] = ps - tl; geo[NE + 1 + tid] = c; }
                if (tid == NE - 1) geo[NE] = ps;
            }
            __syncthreads();
            const int ng2 = (l + 1 < DEPTH && l + 1 >= CVPRO) ? nblk - CV2 : nblk;
            if (bid < ng2) {
                pg8::MoeProb S{(const unsigned char*)ACT, ws + WT_DN + (size_t)l * NE * 1024 * 1024, (size_t)1024 * 1024, (const int*)(ws + WS_RTOK), geo, (const LAS unsigned*)(lds + LDS_ROWTAB), FF, FF, 4, ng2, bid, 0, 124, 122};
                S.fill_rowtab<1, 6>((LAS unsigned*)(lds + LDS_ROWTAB), tid); __syncthreads();
                pg8::EpY8 E{(unsigned char*)Y, (const LAS unsigned*)(lds + LDS_ROWTAB)}; pg8::gemm_phase(lds, S, E, FF);
            } else convert_moe(p, l + 1, CVSPLIT, CV_LAYER_ITEMS, (bid - ng2) * NWV + (otid() >> 6), CV2 * NWV, lds + (otid() >> 6) * 16384, otid() & 63); }  PH_END
    }
    PH_BEGIN  phase_norm<2>(p, DEPTH, bid, nblk, ldsf, -1, XOUT);  PH_END
#undef PH_BEGIN
#undef PH_END
}

#ifndef MK_ONE_LAUNCH
#define MK_ONE_LAUNCH 1
#endif
extern "C" void kernel_launch(void* const* d_in, const int* in_sizes, int n_in, void* d_out, int out_size, void* d_ws, size_t ws_size, hipStream_t stream) {
    (void)in_sizes; (void)n_in; (void)out_size;
    if (ws_size < WS_END) return;
    P p{};
    const float* const* in = (const float* const*)d_in;
    p.x = in[0]; p.c = in[1]; p.ada_w = in[2]; p.ada_b = in[3]; p.norm_g = in[4]; p.final_norm_g = in[5];
    p.pool_w_in = in[6]; p.pool_w_grp = in[7]; p.pool_scale = in[8]; p.pool_w_out = in[9];
    p.hgrn_w_in = in[10]; p.hgrn_lb_logits = in[11]; p.hgrn_norm_g = in[12]; p.hgrn_w_out = in[13];
    p.swa_w_in = in[14]; p.swa_sinks = in[15]; p.swa_w_out = in[16];
    p.conv_w_in = in[17]; p.conv_w = in[18]; p.conv_w_out = in[19];
    p.router_w = in[20]; p.router_bias = in[21]; p.moe_w_gate = in[22]; p.moe_w_up = in[23]; p.moe_w_down = in[24];
    p.X = (float*)d_out; p.ws = (unsigned char*)d_ws;
    static int grid = 0;
    if (grid == 0) {
        int dev = 0, cus = 0;
        if (hipGetDevice(&dev) != hipSuccess || hipDeviceGetAttribute(&cus, hipDeviceAttributeMultiprocessorCount, dev) != hipSuccess) { grid = -1; return; }
        if (hipFuncSetAttribute((const void*)mega, hipFuncAttributeMaxDynamicSharedMemorySize, LDS_BYTES) != hipSuccess) { grid = -1; return; }
        grid = (cus >= 256) ? 256 : -1;
    }
    if (grid < 0) return;
    (void)hipMemsetAsync((unsigned char*)d_ws + WS_CTL, 0, CTL_BYTES, stream);
#if MK_ONE_LAUNCH
    hipLaunchKernelGGL(mega, dim3(grid), dim3(NT), LDS_BYTES, stream, p, 0, NPHASE);
#else
    for (int k = 0; k < NPHASE; ++k) hipLaunchKernelGGL(mega, dim3(grid), dim3(NT), LDS_BYTES, stream, p, k, k + 1);
#endif
}
```
